# Optimizing an MI355X kernel written in HIP

```python
import math
import jax, jax.numpy as jnp
from jax import lax
import numpy as np

D_MODEL = 1024
BATCH = 16
SEQ = 4096
DEPTH = 4

D_FF = 2816
MLA_HEADS = 8
MLA_Q_RANK = 384
MLA_KV_RANK = 256
MLA_NOPE_DIM = 64
MLA_ROPE_DIM = 32
MLA_V_DIM = 64
ROPE_THETA = 10000.0
DIL_PAIRS = ((128, 1), (512, 4), (2048, 16))
DIL_HEADS_PER_GROUP = 4
DIL_HEADS = DIL_HEADS_PER_GROUP * len(DIL_PAIRS)
DIL_HEAD_DIM = 128
SSM_WIDTH = 512
SSM_GROUP_SIZE = 16
SSM_GROUPS = SSM_WIDTH // SSM_GROUP_SIZE
SSM_STATE = 64
SSM_CHUNK = 128
N_BRANCH = 3
BRANCH_WIDTH = 512
Q_BLOCK = 128
N_IN = MLA_Q_RANK + MLA_KV_RANK + MLA_ROPE_DIM + 3 * DIL_HEADS * DIL_HEAD_DIM + SSM_WIDTH + N_BRANCH * D_MODEL
SPLIT_POINTS = (
    MLA_Q_RANK,
    MLA_Q_RANK + MLA_KV_RANK,
    MLA_Q_RANK + MLA_KV_RANK + MLA_ROPE_DIM,
    MLA_Q_RANK + MLA_KV_RANK + MLA_ROPE_DIM + 3 * DIL_HEADS * DIL_HEAD_DIM,
    MLA_Q_RANK + MLA_KV_RANK + MLA_ROPE_DIM + 3 * DIL_HEADS * DIL_HEAD_DIM + SSM_WIDTH,
)
DEEPNORM_ALPHA = (2 * DEPTH) ** 0.25
DEEPNORM_BETA = (8 * DEPTH) ** -0.25
MACARON_WEIGHT = 0.5
LN_EPS = 1e-5
RMS_EPS = 1e-6

kernel_name = 'hybrid_mla_dilated_s5_macaron_deepnorm'


def layer_norm(x, g, b):
    xf = x.astype(jnp.float32)
    mu = jnp.mean(xf, axis=-1, keepdims=True)
    var = jnp.mean(jnp.square(xf - mu), axis=-1, keepdims=True)
    return ((xf - mu) * lax.rsqrt(var + LN_EPS)).astype(x.dtype) * g + b


def rms_norm(x, g):
    xf = x.astype(jnp.float32)
    return (xf * lax.rsqrt(jnp.mean(xf * xf, axis=-1, keepdims=True) + RMS_EPS)).astype(x.dtype) * g


def modulate(h, shift, scale):
    return h * (1.0 + scale[:, None, :]) + shift[:, None, :]


def post_norm(h, out, res_w, gate, g, b):
    return layer_norm(DEEPNORM_ALPHA * h + res_w * gate[:, None, :] * out, g, b)


def swiglu(h, w1, w3, w2):
    return (jax.nn.silu(h @ w1) * (h @ w3)) @ w2


def alibi_slopes(n):
    return jnp.exp2(-8.0 * (jnp.arange(n, dtype=jnp.float32) + 1.0) / n)


def rope(t, positions):
    half = MLA_ROPE_DIM // 2
    inv_freq = jnp.power(ROPE_THETA, -jnp.arange(half, dtype=jnp.float32) / half)
    ang = positions.astype(jnp.float32)[..., None] * inv_freq
    ang = ang.reshape(ang.shape[:2] + (1,) * (t.ndim - 3) + (half,))
    cos, sin = jnp.cos(ang), jnp.sin(ang)
    tf = t.astype(jnp.float32)
    t1, t2 = tf[..., :half], tf[..., half:]
    return jnp.concatenate([t1 * cos - t2 * sin, t2 * cos + t1 * sin], axis=-1).astype(t.dtype)


def causal_block_attention(q, k, v, scale):
    B, S, H, _ = q.shape
    nb = S // Q_BLOCK
    kpos = jnp.arange(S)

    def one_block(j):
        qb = lax.dynamic_slice_in_dim(q, j * Q_BLOCK, Q_BLOCK, axis=1)
        s = jnp.einsum('bqhd,bkhd->bhqk', qb, k, preferred_element_type=jnp.float32) * scale
        qpos = j * Q_BLOCK + jnp.arange(Q_BLOCK)
        s = jnp.where(kpos[None, :] <= qpos[:, None], s, -jnp.inf)
        p = jax.nn.softmax(s, axis=-1).astype(v.dtype)
        return jnp.einsum('bhqk,bkhd->bqhd', p, v)

    out = lax.map(one_block, jnp.arange(nb))
    return out.transpose(1, 0, 2, 3, 4).reshape(B, S, H, v.shape[-1])


def banded_causal_attention(q, k, v, band, slopes, stride, scale):
    N, L, H, dh = q.shape
    nb = -(-L // Q_BLOCK)
    pad = nb * Q_BLOCK - L
    q = jnp.pad(q, ((0, 0), (0, pad), (0, 0), (0, 0)))
    k = jnp.pad(k, ((0, 0), (Q_BLOCK, pad), (0, 0), (0, 0)))
    v = jnp.pad(v, ((0, 0), (Q_BLOCK, pad), (0, 0), (0, 0)))
    qi = jnp.arange(Q_BLOCK)
    ki = jnp.arange(2 * Q_BLOCK)
    rel = qi[:, None] - ki[None, :] + Q_BLOCK
    band_ok = (rel >= 0) & (rel <= band)
    bias = -(slopes.astype(jnp.float32) * stride)[:, None, None] * rel.astype(jnp.float32)

    def one_block(j):
        qb = lax.dynamic_slice_in_dim(q, j * Q_BLOCK, Q_BLOCK, axis=1)
        kb = lax.dynamic_slice_in_dim(k, j * Q_BLOCK, 2 * Q_BLOCK, axis=1)
        vb = lax.dynamic_slice_in_dim(v, j * Q_BLOCK, 2 * Q_BLOCK, axis=1)
        s = jnp.einsum('nqhd,nkhd->nhqk', qb, kb, preferred_element_type=jnp.float32) * scale + bias
        key_ok = band_ok & ((j * Q_BLOCK - Q_BLOCK + ki) >= 0)[None, :]
        s = jnp.where(key_ok, s, -jnp.inf)
        lse = jax.nn.logsumexp(s, axis=-1)
        p = jnp.exp(s - lse[..., None]).astype(v.dtype)
        o = jnp.einsum('nhqk,nkhd->nqhd', p, vb)
        return o, lse.transpose(0, 2, 1)

    o, lse = lax.map(one_block, jnp.arange(nb))
    o = o.transpose(1, 0, 2, 3, 4).reshape(N, nb * Q_BLOCK, H, dh)[:, :L]
    lse = lse.transpose(1, 0, 2, 3).reshape(N, nb * Q_BLOCK, H)[:, :L]
    return o, lse


def to_strided(t, dil):
    B, S, H, d = t.shape
    return t.reshape(B, S // dil, dil, H, d).transpose(0, 2, 1, 3, 4).reshape(B * dil, S // dil, H, d)


def from_strided(t, B, dil):
    L = t.shape[1]
    rest = t.shape[2:]
    t = t.reshape((B, dil, L) + rest)
    t = jnp.moveaxis(t, 1, 2)
    return t.reshape((B, L * dil) + rest)


def dilated_attention(q, k, v):
    B = q.shape[0]
    slopes = alibi_slopes(DIL_HEADS)
    outs, lses = [], []
    for g, (window, dil) in enumerate(DIL_PAIRS):
        lo, hi = g * DIL_HEADS_PER_GROUP, (g + 1) * DIL_HEADS_PER_GROUP
        o, lse = banded_causal_attention(
            to_strided(q[:, :, lo:hi], dil), to_strided(k[:, :, lo:hi], dil), to_strided(v[:, :, lo:hi], dil),
            window // dil, slopes[lo:hi], dil, DIL_HEAD_DIM ** -0.5)
        outs.append(from_strided(o, B, dil))
        lses.append(from_strided(lse, B, dil))
    w = jax.nn.softmax(jnp.stack(lses, axis=0), axis=0)
    o = jnp.stack(outs, axis=0)
    return jnp.einsum('gbsh,gbshd->bshd', w.astype(o.dtype), o)


def s5_ssm(u, lam_re, lam_im, log_dt, b_re, b_im, c_re, c_im, d_skip):
    B, S, _ = u.shape
    f32 = jnp.float32
    uf = u.astype(f32)
    lam = lax.complex(lam_re.astype(f32), lam_im.astype(f32))
    dt = jnp.exp(log_dt.astype(f32))[:, None]
    lam_bar = jnp.exp(lam * dt)
    b_bar = ((lam_bar - 1.0) / lam)[..., None] * lax.complex(b_re.astype(f32), b_im.astype(f32))
    c_mat = lax.complex(c_re.astype(f32), c_im.astype(f32))
    nc = S // SSM_CHUNK
    u_chunks = uf.reshape(B, nc, SSM_CHUNK, SSM_GROUPS, SSM_GROUP_SIZE).transpose(1, 2, 0, 3, 4)
    a = jnp.broadcast_to(lam_bar, (SSM_CHUNK, 1, SSM_GROUPS, SSM_STATE))

    def combine(e1, e2):
        a1, b1 = e1
        a2, b2 = e2
        return a2 * a1, a2 * b1 + b2

    def chunk_step(state, u_c):
        bu = jnp.einsum('gph,tbgh->tbgp', b_bar, u_c.astype(jnp.complex64))
        a_cum, xs = lax.associative_scan(combine, (a, bu), axis=0)
        xs = xs + a_cum * state[None]
        y = jnp.einsum('gkp,tbgp->tbgk', c_mat, xs).real
        return xs[-1], y

    state0 = jnp.zeros((B, SSM_GROUPS, SSM_STATE), jnp.complex64)
    _, y = lax.scan(chunk_step, state0, u_chunks)
    y = y.transpose(2, 0, 1, 3, 4).reshape(B, S, SSM_WIDTH)
    return y + d_skip.astype(f32) * uf


def token_mixer(h, positions, w_in, b_in, q_norm, kv_norm, w_qb, w_kvb,
                lam_re, lam_im, log_dt, b_re, b_im, c_re, c_im, d_skip, w_glu, b_glu, w_br, w_out):
    B, S, _ = h.shape
    proj = h @ w_in + b_in
    q_a, kv_a, k_rope, dil_qkv, u, gate_logits = jnp.split(proj, SPLIT_POINTS, axis=-1)

    q = (rms_norm(q_a, q_norm) @ w_qb).reshape(B, S, MLA_HEADS, MLA_NOPE_DIM + MLA_ROPE_DIM)
    q = jnp.concatenate([q[..., :MLA_NOPE_DIM], rope(q[..., MLA_NOPE_DIM:], positions)], axis=-1)
    kv = (rms_norm(kv_a, kv_norm) @ w_kvb).reshape(B, S, MLA_HEADS, MLA_NOPE_DIM + MLA_V_DIM)
    k_pe = jnp.broadcast_to(rope(k_rope, positions)[:, :, None, :], (B, S, MLA_HEADS, MLA_ROPE_DIM))
    k = jnp.concatenate([kv[..., :MLA_NOPE_DIM], k_pe], axis=-1)
    y_mla = causal_block_attention(q, k, kv[..., MLA_NOPE_DIM:], (MLA_NOPE_DIM + MLA_ROPE_DIM) ** -0.5)
    y_mla = y_mla.reshape(B, S, BRANCH_WIDTH)

    qkv = dil_qkv.reshape(B, S, 3, DIL_HEADS, DIL_HEAD_DIM)
    y_dil = dilated_attention(qkv[:, :, 0], qkv[:, :, 1], qkv[:, :, 2]).reshape(B, S, BRANCH_WIDTH)

    y_ssm = jax.nn.gelu(s5_ssm(u, lam_re, lam_im, log_dt, b_re, b_im, c_re, c_im, d_skip)).astype(h.dtype)
    y_ssm = y_ssm * jax.nn.sigmoid(y_ssm @ w_glu + b_glu)

    gates = jax.nn.sigmoid(gate_logits).reshape(B, S, N_BRANCH, D_MODEL)
    merged = (gates[:, :, 0] * (y_mla @ w_br[0])
              + gates[:, :, 1] * (y_dil @ w_br[1])
              + gates[:, :, 2] * (y_ssm @ w_br[2]))
    return merged @ w_out


def setup_inputs(seed: int = 0) -> dict:
    key = jax.random.key(seed)
    ks = iter(jax.random.split(key, 40))
    f32 = jnp.float32
    L, D = DEPTH, D_MODEL

    def nrm(shape, scale):
        return jax.random.normal(next(ks), shape, f32) * scale

    x = nrm((BATCH, SEQ, D), 1.0)
    c = nrm((BATCH, D), 1.0)
    offset = jax.random.randint(next(ks), (BATCH, 1), 0, 1024, dtype=jnp.int32)
    positions = offset + jnp.arange(SEQ, dtype=jnp.int32)[None, :]
    w_ada = nrm((L, D, 9 * D), D ** -0.5)
    b_ada = nrm((L, 9 * D), 0.02)
    ln_g = 1.0 + nrm((L, 3, D), 0.02)
    ln_b = nrm((L, 3, D), 0.02)
    ffn_w1 = nrm((L, 2, D, D_FF), D ** -0.5)
    ffn_w3 = nrm((L, 2, D, D_FF), D ** -0.5)
    ffn_w2 = nrm((L, 2, D_FF, D), D_FF ** -0.5 * DEEPNORM_BETA)
    w_in = nrm((L, D, N_IN), D ** -0.5)
    b_in = nrm((L, N_IN), 0.02)
    mla_q_norm = 1.0 + nrm((L, MLA_Q_RANK), 0.02)
    mla_kv_norm = 1.0 + nrm((L, MLA_KV_RANK), 0.02)
    mla_w_qb = nrm((L, MLA_Q_RANK, MLA_HEADS * (MLA_NOPE_DIM + MLA_ROPE_DIM)), MLA_Q_RANK ** -0.5)
    mla_w_kvb = nrm((L, MLA_KV_RANK, MLA_HEADS * (MLA_NOPE_DIM + MLA_V_DIM)), MLA_KV_RANK ** -0.5)
    n_idx = jnp.arange(SSM_STATE, dtype=f32)
    ssm_lambda_re = -0.5 + nrm((L, SSM_GROUPS, SSM_STATE), 0.01)
    ssm_lambda_im = math.pi * n_idx + nrm((L, SSM_GROUPS, SSM_STATE), 0.01)
    ssm_log_dt = jax.random.uniform(next(ks), (L, SSM_GROUPS), f32, math.log(1e-3), math.log(1e-1))
    ssm_b_re = nrm((L, SSM_GROUPS, SSM_STATE, SSM_GROUP_SIZE), (2 * SSM_GROUP_SIZE) ** -0.5)
    ssm_b_im = nrm((L, SSM_GROUPS, SSM_STATE, SSM_GROUP_SIZE), (2 * SSM_GROUP_SIZE) ** -0.5)
    ssm_c_re = nrm((L, SSM_GROUPS, SSM_GROUP_SIZE, SSM_STATE), (2 * SSM_STATE) ** -0.5)
    ssm_c_im = nrm((L, SSM_GROUPS, SSM_GROUP_SIZE, SSM_STATE), (2 * SSM_STATE) ** -0.5)
    ssm_d = nrm((L, SSM_WIDTH), 1.0)
    ssm_w_glu = nrm((L, SSM_WIDTH, SSM_WIDTH), SSM_WIDTH ** -0.5)
    ssm_b_glu = nrm((L, SSM_WIDTH), 0.02)
    w_br = nrm((L, N_BRANCH, BRANCH_WIDTH, D), BRANCH_WIDTH ** -0.5)
    w_out = nrm((L, D, D), D ** -0.5 * DEEPNORM_BETA)
    return {
        'x': x, 'c': c, 'positions': positions,
        'w_ada': w_ada, 'b_ada': b_ada, 'ln_g': ln_g, 'ln_b': ln_b,
        'ffn_w1': ffn_w1, 'ffn_w3': ffn_w3, 'ffn_w2': ffn_w2,
        'w_in': w_in, 'b_in': b_in,
        'mla_q_norm': mla_q_norm, 'mla_kv_norm': mla_kv_norm, 'mla_w_qb': mla_w_qb, 'mla_w_kvb': mla_w_kvb,
        'ssm_lambda_re': ssm_lambda_re, 'ssm_lambda_im': ssm_lambda_im, 'ssm_log_dt': ssm_log_dt,
        'ssm_b_re': ssm_b_re, 'ssm_b_im': ssm_b_im, 'ssm_c_re': ssm_c_re, 'ssm_c_im': ssm_c_im,
        'ssm_d': ssm_d, 'ssm_w_glu': ssm_w_glu, 'ssm_b_glu': ssm_b_glu,
        'w_br': w_br, 'w_out': w_out,
    }


def reference(x, c, positions, w_ada, b_ada, ln_g, ln_b, ffn_w1, ffn_w3, ffn_w2, w_in, b_in,
              mla_q_norm, mla_kv_norm, mla_w_qb, mla_w_kvb,
              ssm_lambda_re, ssm_lambda_im, ssm_log_dt, ssm_b_re, ssm_b_im, ssm_c_re, ssm_c_im,
              ssm_d, ssm_w_glu, ssm_b_glu, w_br, w_out):
    B, S, D = x.shape
    h = x
    cond = jax.nn.silu(c)
    for l in range(DEPTH):
        ada = (cond @ w_ada[l] + b_ada[l]).reshape(B, 3, 3, D)
        f = swiglu(modulate(h, ada[:, 0, 0], ada[:, 0, 1]), ffn_w1[l, 0], ffn_w3[l, 0], ffn_w2[l, 0])
        h = post_norm(h, f, MACARON_WEIGHT, ada[:, 0, 2], ln_g[l, 0], ln_b[l, 0])
        m = token_mixer(modulate(h, ada[:, 1, 0], ada[:, 1, 1]), positions, w_in[l], b_in[l],
                        mla_q_norm[l], mla_kv_norm[l], mla_w_qb[l], mla_w_kvb[l],
                        ssm_lambda_re[l], ssm_lambda_im[l], ssm_log_dt[l], ssm_b_re[l], ssm_b_im[l],
                        ssm_c_re[l], ssm_c_im[l], ssm_d[l], ssm_w_glu[l], ssm_b_glu[l], w_br[l], w_out[l])
        h = post_norm(h, m, 1.0, ada[:, 1, 2], ln_g[l, 1], ln_b[l, 1])
        f = swiglu(modulate(h, ada[:, 2, 0], ada[:, 2, 1]), ffn_w1[l, 1], ffn_w3[l, 1], ffn_w2[l, 1])
        h = post_norm(h, f, MACARON_WEIGHT, ada[:, 2, 2], ln_g[l, 2], ln_b[l, 2])
    return h
```

```cpp
#include <hip/hip_runtime.h>
#include <cstdio>
#include <cstdint>
#include <cmath>
namespace pg8 {
#define PG8_LAS __attribute__((address_space(3)))
typedef unsigned short bf16_t;
typedef short bf16x8 __attribute__((ext_vector_type(8)));
typedef float f32x4 __attribute__((ext_vector_type(4)));
typedef unsigned u32x4 __attribute__((ext_vector_type(4)));
constexpr int BM = 256, BK = 64, HALF = 128, HTB = HALF * BK * 2  , STAGE_BYTES = 8 * HTB, NXCD = 8, WGM = 8;

__host__ __device__ __forceinline__ int lds_byte(int r, int c) { const int st = (r >> 4) * 2 + (c >> 5), rr = r & 15, cc = c & 31, ob = rr * 64 + cc * 2; return st * 1024 + (ob ^ (((ob >> 9) & 1) << 5)); }
__host__ __device__ __forceinline__ void stage_rc(int b, int& R, int& C) { const int st = b / 1024, sb = b % 1024, swz = sb ^ (((sb >> 9) & 1) << 5); R = (st >> 1) * 16 + swz / 64; C = (st & 1) * 32 + (swz % 64) / 2; }
__host__ __device__ __forceinline__ int perm32(int rho) { const int n = rho >> 4, i = rho & 15; return 8 * (i >> 2) + 4 * n + (i & 3); }

struct Unit { int pm, pn; };
struct Gemm { const bf16_t* A; const bf16_t* Bt; int M, N, K; int lda, ldb; int asplit; long astride; };

struct StaticOrder {
    int nM, nN, nwg, G, c;
    __host__ __device__ void init(int M, int N, int G_, int c_) { nM = M / BM; nN = N / BM; nwg = nM * nN; G = G_; c = c_; }
    __host__ __device__ bool next(int i, Unit& u) const {
        const long L = (long)i * G + c; if (L >= nwg) return false;
        int wgid = (int)L; { const int q = nwg / NXCD, r = nwg % NXCD, xcd = wgid % NXCD, off = wgid / NXCD; wgid = (xcd < r ? xcd * (q + 1) : r * (q + 1) + (xcd - r) * q) + off; }
        const int nig = WGM * nN, gid = wgid / nig, fm = gid * WGM, gsz = (nM - fm) < WGM ? (nM - fm) : WGM;
        u.pm = fm + ((wgid % nig) % gsz); u.pn = (wgid % nig) / gsz; return true;
    }
    __device__ __forceinline__ void a_ready(const Unit&) const {}
    __device__ __forceinline__ void done(const Unit&) const {}
};

__device__ __forceinline__ unsigned cvt_pk_bf16(float lo, float hi) { unsigned r; asm volatile("v_cvt_pk_bf16_f32 %0, %1, %2" : "=v"(r) : "v"(lo), "v"(hi)); return r; }
typedef float f32x2 __attribute__((ext_vector_type(2)));
__device__ __forceinline__ f32x2 gelu_pk(f32x2 v) {
    const f32x2 av = __builtin_elementwise_abs(v), d = av * 0.2316418882f + 1.0f;
    f32x2 t; t.x = __builtin_amdgcn_rcpf(d.x); t.y = __builtin_amdgcn_rcpf(d.y);
    f32x2 q = t * 0.5307027145f + (-0.7265760135f); q = q * t + 0.7107068705f; q = q * t + (-0.142248368f); q = q * t + 0.127414796f; q = q * t;
    const f32x2 s = (v * v) * (-0.72134752044f);
    f32x2 e; e.x = __builtin_amdgcn_exp2f(s.x); e.y = __builtin_amdgcn_exp2f(s.y);
    const f32x2 m = v * (q * e), r = v - m;
    f32x2 o; o.x = v.x < 0.f ? m.x : r.x; o.y = v.y < 0.f ? m.y : r.y; return o;
}

template <int ACT  > struct EpiBf16 {
    static constexpr bool PERM = true, AFTER_DRAIN = false; static_assert(ACT == 0 || ACT == 1, "EpiBf16: ACT is 0 (none) or 1 (gelu_pk)");
    bf16_t* O; int ldc; const float* bias; int split_cols; size_t split_stride; float scale0;
    __device__ __forceinline__ void operator()(const f32x4 (&acc)[2][2][4][2], const Unit& u, int wr, int wc, int fr, int fq) const {
        const int row0 = u.pm * BM + wr * 64 + fr; int colt = u.pn * BM; bf16_t* base = O;
        float sc = 1.f; if (split_cols) { const int t = colt / split_cols; base += (size_t)t * split_stride; colt -= t * split_cols; if (t == 0) sc = scale0; }
        const int col0 = colt + wc * 32 + 8 * fq, bcol0 = u.pn * BM + wc * 32 + 8 * fq;
        f32x4 bv[2][2];
#pragma unroll
        for (int bj = 0; bj < 2; ++bj)
#pragma unroll
            for (int n = 0; n < 2; ++n) bv[bj][n] = bias ? *(const f32x4*)(bias + bcol0 + bj * HALF + 4 * n) : (f32x4){0.f, 0.f, 0.f, 0.f};
#pragma unroll
        for (int ai = 0; ai < 2; ++ai)
#pragma unroll
            for (int m = 0; m < 4; ++m) { bf16_t* rowp = base + (size_t)(row0 + ai * HALF + m * 16) * ldc + col0;
#pragma unroll
                for (int bj = 0; bj < 2; ++bj) { f32x4 v0 = acc[ai][bj][m][0] + bv[bj][0], v1 = acc[ai][bj][m][1] + bv[bj][1];
                    if (ACT == 1) { f32x2 a = gelu_pk((f32x2){v0[0], v0[1]}), b = gelu_pk((f32x2){v0[2], v0[3]}), c = gelu_pk((f32x2){v1[0], v1[1]}), d = gelu_pk((f32x2){v1[2], v1[3]});
                        v0 = (f32x4){a.x, a.y, b.x, b.y}; v1 = (f32x4){c.x, c.y, d.x, d.y}; }
                    v0 = v0 * sc; v1 = v1 * sc; u32x4 w; w.x = cvt_pk_bf16(v0[0], v0[1]); w.y = cvt_pk_bf16(v0[2], v0[3]); w.z = cvt_pk_bf16(v1[0], v1[1]); w.w = cvt_pk_bf16(v1[2], v1[3]);
                    *(u32x4*)(rowp + bj * HALF) = w; } }
    }
};

struct PanelStats {
    unsigned* xbuf;
    unsigned* cnt;
    unsigned* tmo;
    int ntn; float eps;
    unsigned code;
    __device__ __forceinline__ bool run(const f32x4 (&v)[2][2][4][2], const Unit& u, int wr, int wc, int fr, int fq, PG8_LAS unsigned char* lds, int wid, int lane) const {
        typedef float f32x2v __attribute__((ext_vector_type(2)));
        PG8_LAS f32x2v* P = (PG8_LAS f32x2v*)lds;
        PG8_LAS f32x2v* S = (PG8_LAS f32x2v*)(lds + 8192);
        PG8_LAS unsigned* flag = (PG8_LAS unsigned*)(lds + 8192 + 2048);
#pragma unroll
        for (int ai = 0; ai < 2; ++ai)
#pragma unroll
            for (int m = 0; m < 4; ++m) {
                float s = 0.f;
#pragma unroll
                for (int bj = 0; bj < 2; ++bj)
#pragma unroll
                    for (int n = 0; n < 2; ++n) { const f32x4 x = v[ai][bj][m][n]; s += (x[0] + x[1]) + (x[2] + x[3]); }
                s += __shfl_xor(s, 16); s += __shfl_xor(s, 32);
                const float mw = s * (1.0f / 64.0f); float q = 0.f;
#pragma unroll
                for (int bj = 0; bj < 2; ++bj)
#pragma unroll
                    for (int n = 0; n < 2; ++n) { const f32x4 d = v[ai][bj][m][n] - mw; q += (d[0] * d[0] + d[1] * d[1]) + (d[2] * d[2] + d[3] * d[3]); }
                q += __shfl_xor(q, 16); q += __shfl_xor(q, 32);
                if (fq == 0) P[(ai * HALF + wr * 64 + m * 16 + fr) * 4 + wc] = (f32x2v){mw, q};
            }
        asm volatile("s_waitcnt lgkmcnt(0)" ::: "memory"); __builtin_amdgcn_s_barrier(); asm volatile("" ::: "memory");
#if defined(BROKEN_EXCHANGE_NO_WAIT)
#warning BROKEN CONTROL BUILD: the row-statistics exchange does not wait; results are wrong by design
        if (blockIdx.x >= 64) { const long long t0_ = clock64(); while (clock64() - t0_ < 60000) __builtin_amdgcn_s_sleep(8); }
#endif
        const int row = wid * 32 + (lane & 31);
        if (lane < 32) {
            const f32x2v a = P[row * 4 + 0], b = P[row * 4 + 1], c = P[row * 4 + 2], d = P[row * 4 + 3];
            const float mt = (a.x + b.x + c.x + d.x) * 0.25f;
            const float da = a.x - mt, db = b.x - mt, dc = c.x - mt, dd = d.x - mt;
            const float m2 = (a.y + b.y) + (c.y + d.y) + 64.0f * ((da * da + db * db) + (dc * dc + dd * dd));
            unsigned long long* slot = (unsigned long long*)xbuf + ((size_t)(u.pm * BM + row) * 4 + u.pn);
            __hip_atomic_store(slot, ((unsigned long long)__float_as_uint(m2) << 32) | __float_as_uint(mt), __ATOMIC_RELAXED, __HIP_MEMORY_SCOPE_AGENT);
        }
        asm volatile("s_waitcnt vmcnt(0)" ::: "memory");
        if (lane == 0) __hip_atomic_fetch_add(cnt + 64 * u.pm, 1u, __ATOMIC_RELAXED, __HIP_MEMORY_SCOPE_AGENT);
        if (wid == 0) {
            bool dead = false; const unsigned long long t0 = __builtin_amdgcn_s_memrealtime(); const unsigned want = 8u * (unsigned)ntn;
            for (;;) {
#if defined(BROKEN_EXCHANGE_NO_WAIT)
                break;
#endif
                if ((unsigned)__builtin_amdgcn_readfirstlane(__hip_atomic_load(cnt + 64 * u.pm, __ATOMIC_RELAXED, __HIP_MEMORY_SCOPE_AGENT)) >= want) break;
                if (__builtin_amdgcn_s_memrealtime() - t0 > 2000000ull) {
                    if (lane == 0) { unsigned expect = 0u; __hip_atomic_compare_exchange_strong(tmo + 1, &expect, code | (unsigned)(u.pm & 0xff), __ATOMIC_RELAXED, __ATOMIC_RELAXED, __HIP_MEMORY_SCOPE_AGENT);
                                     __hip_atomic_store(tmo, 1u, __ATOMIC_RELAXED, __HIP_MEMORY_SCOPE_AGENT); }
                    dead = true; break; }
                __builtin_amdgcn_s_sleep(2);
            }
            __builtin_amdgcn_fence(__ATOMIC_ACQUIRE, "agent");
            if (lane == 0) flag[0] = dead ? 1u : 0u;
        }
        asm volatile("s_waitcnt vmcnt(0) lgkmcnt(0)" ::: "memory"); __builtin_amdgcn_s_barrier(); asm volatile("" ::: "memory");
        const bool bad = flag[0] != 0u;
        if (lane < 32) {
            const unsigned long long* slot = (const unsigned long long*)xbuf + (size_t)(u.pm * BM + row) * 4; float mt[4], m2[4]; float ms = 0.f;
#pragma unroll
            for (int t = 0; t < 4; ++t) { if (t < ntn) { const unsigned long long w = __hip_atomic_load(slot + t, __ATOMIC_RELAXED, __HIP_MEMORY_SCOPE_AGENT); mt[t] = __uint_as_float((unsigned)w); m2[t] = __uint_as_float((unsigned)(w >> 32)); } else { mt[t] = 0.f; m2[t] = 0.f; } ms += mt[t]; }
            const float mean = ms / (float)ntn; float q = 0.f;
#pragma unroll
            for (int t = 0; t < 4; ++t) if (t < ntn) { const float dm = mt[t] - mean; q += m2[t] + 256.0f * dm * dm; }
            S[row] = (f32x2v){mean, 1.0f / sqrtf(q / (256.0f * (float)ntn) + eps)};
        }
        asm volatile("s_waitcnt lgkmcnt(0)" ::: "memory"); __builtin_amdgcn_s_barrier(); asm volatile("" ::: "memory");
        return bad;
    }
};
struct EpiLnRes {
    static constexpr bool PERM = false, AFTER_DRAIN = true;
    const float* base; float* out; int ldc; const float* bias; PanelStats st; unsigned poison;
    __device__ __forceinline__ void fused(f32x4 (&acc)[2][2][4][2], const Unit& u, int wr, int wc, int fr, int fq, PG8_LAS unsigned char* lds, int wid, int lane) const {
        typedef float f32x2v __attribute__((ext_vector_type(2)));
        const PG8_LAS f32x2v* S = (const PG8_LAS f32x2v*)(lds + 8192);
        const int col0 = u.pn * BM + wc * 32 + 4 * fq;
#pragma unroll
        for (int bj = 0; bj < 2; ++bj)
#pragma unroll
            for (int n = 0; n < 2; ++n) { const f32x4 bv = bias ? *(const f32x4*)(bias + col0 + bj * HALF + n * 16) : (f32x4){0.f, 0.f, 0.f, 0.f};
#pragma unroll
                for (int ai = 0; ai < 2; ++ai)
#pragma unroll
                    for (int m = 0; m < 4; ++m) acc[ai][bj][m][n] += bv; }
        f32x4 pre[4][2][2];
#pragma unroll
        for (int m = 0; m < 4; ++m) { const size_t off = (size_t)(u.pm * BM + wr * 64 + m * 16 + fr) * ldc + col0;
#pragma unroll
            for (int bj = 0; bj < 2; ++bj)
#pragma unroll
                for (int n = 0; n < 2; ++n) pre[m][bj][n] = *(const f32x4*)(base + off + bj * HALF + n * 16); }
        const bool bad = st.run(acc, u, wr, wc, fr, fq, lds, wid, lane) || poison != 0u;
        const float qnan = __builtin_nanf("");
#pragma unroll
        for (int ai = 0; ai < 2; ++ai)
#pragma unroll
            for (int m = 0; m < 4; ++m) { const int r = ai * HALF + wr * 64 + m * 16 + fr; const f32x2v sr = S[r]; const size_t off = (size_t)(u.pm * BM + r) * ldc + col0;
#pragma unroll
                for (int bj = 0; bj < 2; ++bj)
#pragma unroll
                    for (int n = 0; n < 2; ++n) { const f32x4 bs = ai == 0 ? pre[m][bj][n] : *(const f32x4*)(base + off + bj * HALF + n * 16); f32x4 o = bs + (acc[ai][bj][m][n] - sr.x) * sr.y;
                        if (bad) o = (f32x4){qnan, qnan, qnan, qnan}; *(f32x4*)(out + off + bj * HALF + n * 16) = o; }
                if (m & 1) asm volatile("" ::: "memory"); }
    }
};
struct EpiLnResLn {
    static constexpr bool PERM = false, AFTER_DRAIN = true;
    const float* base; float* out; bf16_t* xn; int ldc; const float* bias; PanelStats st1, st2; unsigned poison;
    __device__ __forceinline__ void fused(f32x4 (&acc)[2][2][4][2], const Unit& u, int wr, int wc, int fr, int fq, PG8_LAS unsigned char* lds, int wid, int lane) const {
        typedef float f32x2v __attribute__((ext_vector_type(2))); typedef unsigned u32x2v __attribute__((ext_vector_type(2)));
        const PG8_LAS f32x2v* S = (const PG8_LAS f32x2v*)(lds + 8192);
        const int col0 = u.pn * BM + wc * 32 + 4 * fq;
#pragma unroll
        for (int bj = 0; bj < 2; ++bj)
#pragma unroll
            for (int n = 0; n < 2; ++n) { const f32x4 bv = bias ? *(const f32x4*)(bias + col0 + bj * HALF + n * 16) : (f32x4){0.f, 0.f, 0.f, 0.f};
#pragma unroll
                for (int ai = 0; ai < 2; ++ai)
#pragma unroll
                    for (int m = 0; m < 4; ++m) acc[ai][bj][m][n] += bv; }
        bool bad = st1.run(acc, u, wr, wc, fr, fq, lds, wid, lane) || poison != 0u;
        const float qnan = __builtin_nanf("");
#pragma unroll
        for (int ai = 0; ai < 2; ++ai)
#pragma unroll
            for (int m = 0; m < 4; ++m) { const int r = ai * HALF + wr * 64 + m * 16 + fr; const f32x2v sr = S[r]; const size_t off = (size_t)(u.pm * BM + r) * ldc + col0;
#pragma unroll
                for (int bj = 0; bj < 2; ++bj)
#pragma unroll
                    for (int n = 0; n < 2; ++n) { const f32x4 bs = *(const f32x4*)(base + off + bj * HALF + n * 16); acc[ai][bj][m][n] = bs + (acc[ai][bj][m][n] - sr.x) * sr.y; }
                asm volatile("" : "+v"(acc[ai][0][m][0]), "+v"(acc[ai][0][m][1]), "+v"(acc[ai][1][m][0]), "+v"(acc[ai][1][m][1]));
                if (m & 1) asm volatile("" ::: "memory"); }
        const bool bad1 = bad;
        bad = st2.run(acc, u, wr, wc, fr, fq, lds, wid, lane) || bad;
#pragma unroll
        for (int ai = 0; ai < 2; ++ai)
#pragma unroll
            for (int m = 0; m < 4; ++m) { const int r = ai * HALF + wr * 64 + m * 16 + fr; const f32x2v sr = S[r]; const size_t off = (size_t)(u.pm * BM + r) * ldc + col0;
#pragma unroll
                for (int bj = 0; bj < 2; ++bj)
#pragma unroll
                    for (int n = 0; n < 2; ++n) { const f32x4 x1 = acc[ai][bj][m][n]; *(f32x4*)(out + off + bj * HALF + n * 16) = bad1 ? (f32x4){qnan, qnan, qnan, qnan} : x1;
                        const f32x4 o = (x1 - sr.x) * sr.y; u32x2v w; w.x = cvt_pk_bf16(o[0], o[1]); w.y = cvt_pk_bf16(o[2], o[3]);
                        if (bad) { w.x = 0x7fc07fc0u; w.y = 0x7fc07fc0u; } *(u32x2v*)(xn + off + bj * HALF + n * 16) = w; }
                asm volatile("" ::: "memory"); }
    }
};

template <class Epi, class Sched, bool ALIGN_EPI = false, bool SP2 = false>
__device__ __forceinline__ void gemm_phase(PG8_LAS unsigned char* lds, const Gemm g, const Sched& S, const Epi& E) {
    int tid_ = threadIdx.x; asm volatile("" : "+v"(tid_));
    const int tid = tid_, wid = __builtin_amdgcn_readfirstlane(tid >> 6), lane = tid & 63, wr = wid >> 2, wc = wid & 3, fr = lane & 15, fq = lane >> 4;
    const int K = g.K, nt = K / BK;
    unsigned voffA[2], voffB[2];
#pragma unroll
    for (int i = 0; i < 2; ++i) { int R, C; stage_rc(tid * 16 + i * 8192, R, C); const int Rb = Epi::PERM ? ((R & ~31) + perm32(R & 31)) : R;
        voffA[i] = (unsigned)(R * g.lda + C) * 2u; voffB[i] = (unsigned)(Rb * g.ldb + C) * 2u; }
    const size_t kstep = (size_t)(BK * 2);
    const size_t hstepA = (size_t)HALF * g.lda * 2, hstepB = (size_t)HALF * g.ldb * 2;
    const size_t tstepA = 2 * hstepA, tstepB = 2 * hstepB;
#define PG8_UA(u) ((const char*)g.A + (size_t)(u).pm * tstepA + (g.asplit ? (size_t)((u).pn / g.asplit) * (size_t)g.astride * 2 : (size_t)0))
#define PG8_UB(u) ((const char*)g.Bt + (size_t)(u).pn * tstepB)
    const unsigned ldsw = (unsigned)wid * 1024u;
    const int aoff = lds_byte(wr * 64 + fr, fq * 8), boff = lds_byte(wc * 32 + fr, fq * 8);
#define PG8_SA(b, h) (((b) * 2 + (h)) * HTB)
#define PG8_SB(b, h) ((4 + (b) * 2 + (h)) * HTB)
#define PG8_STAGE(bufoff, gbase, voff) do { _Pragma("unroll") for (int _i = 0; _i < 2; ++_i) \
        __builtin_amdgcn_global_load_lds((const unsigned*)((const char*)(gbase) + (voff)[_i]), (PG8_LAS unsigned*)(lds + (bufoff) + ldsw + _i * 8192), 16, 0, 0); } while (0)
#define PG8_LDA(dst, b, h) do { _Pragma("unroll") for (int m = 0; m < 4; ++m) _Pragma("unroll") for (int k = 0; k < 2; ++k) dst[m][k] = *(const PG8_LAS bf16x8*)(lds + PG8_SA(b, h) + aoff + m * 2048 + k * 1024); } while (0)
#define PG8_LDB(dst, b, h) do { _Pragma("unroll") for (int n = 0; n < 2; ++n) _Pragma("unroll") for (int k = 0; k < 2; ++k) dst[n][k] = *(const PG8_LAS bf16x8*)(lds + PG8_SB(b, h) + boff + n * 2048 + k * 1024); } while (0)
#define PG8_MMA(ai, bj, At, Bt) do { __builtin_amdgcn_s_setprio(1); _Pragma("unroll") for (int m = 0; m < 4; ++m) _Pragma("unroll") for (int n = 0; n < 2; ++n) _Pragma("unroll") for (int k = 0; k < 2; ++k) \
        acc[ai][bj][m][n] = __builtin_amdgcn_mfma_f32_16x16x32_bf16(Bt[n][k], At[m][k], acc[ai][bj][m][n], 0, 0, 0); __builtin_amdgcn_s_setprio(0); } while (0)
#define PG8_WAIT_V(n) asm volatile("s_waitcnt vmcnt(" #n ")" ::: "memory")
#define PG8_WAIT_L(n) asm volatile("s_waitcnt lgkmcnt(" #n ")" ::: "memory")
#define PG8_BAR __builtin_amdgcn_s_barrier()
#define PG8_SCHED __builtin_amdgcn_sched_barrier(0)
    Unit cur, nxt; int ui = 0;
    if (!S.next(0, cur)) return;
    f32x4 acc[2][2][4][2];
#pragma unroll
    for (int a = 0; a < 2; ++a)
#pragma unroll
        for (int b = 0; b < 2; ++b)
#pragma unroll
            for (int m = 0; m < 4; ++m)
#pragma unroll
                for (int n = 0; n < 2; ++n) acc[a][b][m][n] = (f32x4){0.f, 0.f, 0.f, 0.f};
    bf16x8 At[4][2], B0[2][2], B1[2][2];
    const char* cA = PG8_UA(cur); const char* cB = PG8_UB(cur);
    S.a_ready(cur);
    if constexpr (SP2) {
        PG8_STAGE(PG8_SB(0, 0), cB, voffB); PG8_STAGE(PG8_SB(0, 1), cB + hstepB, voffB); PG8_STAGE(PG8_SA(0, 0), cA, voffA); PG8_STAGE(PG8_SA(0, 1), cA + hstepA, voffA);
        if (wr == 1) PG8_BAR;
        PG8_WAIT_V(2); PG8_BAR;
        PG8_STAGE(PG8_SB(1, 0), cB + kstep, voffB); PG8_STAGE(PG8_SA(1, 0), cA + kstep, voffA); PG8_STAGE(PG8_SB(1, 1), cB + hstepB + kstep, voffB);
        PG8_WAIT_V(6); PG8_BAR;
    } else {
        PG8_STAGE(PG8_SB(0, 0), cB, voffB); PG8_STAGE(PG8_SA(0, 0), cA, voffA); PG8_STAGE(PG8_SB(0, 1), cB + hstepB, voffB); PG8_STAGE(PG8_SA(0, 1), cA + hstepA, voffA);
        if (wr == 1) PG8_BAR;
        PG8_WAIT_V(4); PG8_BAR;
        PG8_STAGE(PG8_SB(1, 0), cB + kstep, voffB); PG8_STAGE(PG8_SA(1, 0), cA + kstep, voffA); PG8_STAGE(PG8_SB(1, 1), cB + hstepB + kstep, voffB);
        PG8_WAIT_V(6); PG8_BAR;
    }
    for (;;) {
        const bool has_next = S.next(ui + 1, nxt);
        const char* nA = has_next ? PG8_UA(nxt) : cA; const char* nB = has_next ? PG8_UB(nxt) : cB;
        for (int t = 0; t < nt; t += 2) {
            const bool last = (t == nt - 2);
            const char* a1 = cA + (size_t)(t + 1) * kstep;
            const char* a2 = last ? nA : cA + (size_t)(t + 2) * kstep; const char* b2 = last ? nB : cB + (size_t)(t + 2) * kstep;
            const char* a3 = a2 + kstep; const char* b3 = b2 + kstep;
            if (last && has_next) S.a_ready(nxt);
            if constexpr (SP2) {
            PG8_LDB(B0, 0, 0); PG8_LDB(B1, 0, 1); PG8_SCHED; PG8_LDA(At, 0, 0); PG8_STAGE(PG8_SA(1, 1), a1 + hstepA, voffA);
            PG8_WAIT_V(8); PG8_WAIT_L(0); PG8_BAR; PG8_MMA(0, 0, At, B0); PG8_MMA(0, 1, At, B1); PG8_BAR; PG8_SCHED;
            PG8_LDA(At, 0, 1); PG8_STAGE(PG8_SB(0, 0), b2, voffB); PG8_STAGE(PG8_SB(0, 1), b2 + hstepB, voffB); PG8_STAGE(PG8_SA(0, 0), a2, voffA);
            PG8_WAIT_V(8); PG8_WAIT_L(0); PG8_BAR; PG8_MMA(1, 0, At, B0); PG8_MMA(1, 1, At, B1); PG8_BAR; PG8_SCHED;
            PG8_LDB(B0, 1, 0); PG8_LDB(B1, 1, 1); PG8_SCHED; PG8_LDA(At, 1, 0); PG8_STAGE(PG8_SA(0, 1), a2 + hstepA, voffA);
            PG8_WAIT_V(8); PG8_WAIT_L(0); PG8_BAR; PG8_MMA(0, 0, At, B0); PG8_MMA(0, 1, At, B1); PG8_BAR; PG8_SCHED;
            PG8_LDA(At, 1, 1); PG8_STAGE(PG8_SB(1, 0), b3, voffB); PG8_STAGE(PG8_SB(1, 1), b3 + hstepB, voffB); PG8_STAGE(PG8_SA(1, 0), a3, voffA);
            PG8_WAIT_V(8); PG8_WAIT_L(0); PG8_BAR; PG8_MMA(1, 0, At, B0); PG8_MMA(1, 1, At, B1); PG8_BAR; PG8_SCHED;
            } else {
            PG8_LDB(B0, 0, 0); PG8_SCHED; PG8_LDA(At, 0, 0); PG8_STAGE(PG8_SA(1, 1), a1 + hstepA, voffA);
            PG8_WAIT_L(8); PG8_BAR; PG8_WAIT_L(0); PG8_MMA(0, 0, At, B0); PG8_BAR; PG8_SCHED;
            PG8_LDB(B1, 0, 1); PG8_STAGE(PG8_SB(0, 0), b2, voffB);
            PG8_BAR; PG8_WAIT_L(0); PG8_MMA(0, 1, At, B1); PG8_BAR;
            PG8_LDA(At, 0, 1); PG8_STAGE(PG8_SA(0, 0), a2, voffA);
            PG8_BAR; PG8_WAIT_L(0); PG8_MMA(1, 0, At, B0); PG8_BAR; PG8_SCHED;
            PG8_STAGE(PG8_SB(0, 1), b2 + hstepB, voffB);
            PG8_WAIT_V(6); PG8_BAR; PG8_MMA(1, 1, At, B1); PG8_BAR;
            PG8_LDB(B0, 1, 0); PG8_SCHED; PG8_LDA(At, 1, 0); PG8_STAGE(PG8_SA(0, 1), a2 + hstepA, voffA);
            PG8_WAIT_L(8); PG8_BAR; PG8_WAIT_L(0); PG8_MMA(0, 0, At, B0); PG8_BAR; PG8_SCHED;
            PG8_LDB(B1, 1, 1); PG8_STAGE(PG8_SB(1, 0), b3, voffB);
            PG8_BAR; PG8_WAIT_L(0); PG8_MMA(0, 1, At, B1); PG8_BAR;
            PG8_LDA(At, 1, 1); PG8_STAGE(PG8_SA(1, 0), a3, voffA);
            PG8_BAR; PG8_WAIT_L(0); PG8_MMA(1, 0, At, B0); PG8_BAR; PG8_SCHED;
            PG8_STAGE(PG8_SB(1, 1), b3 + hstepB, voffB);
            PG8_WAIT_V(6); PG8_BAR; PG8_MMA(1, 1, At, B1); PG8_BAR;
            }
        }
        if constexpr (ALIGN_EPI) { if (wr == 0) PG8_BAR; }
        if constexpr (!Epi::AFTER_DRAIN) { E(acc, cur, wr, wc, fr, fq); S.done(cur); }
        if (!has_next) break;
#pragma unroll
        for (int a = 0; a < 2; ++a)
#pragma unroll
            for (int b = 0; b < 2; ++b)
#pragma unroll
                for (int m = 0; m < 4; ++m)
#pragma unroll
                    for (int n = 0; n < 2; ++n) acc[a][b][m][n] = (f32x4){0.f, 0.f, 0.f, 0.f};
        cur = nxt; cA = nA; cB = nB; ++ui;
        if constexpr (ALIGN_EPI) { if (wr == 1) PG8_BAR; }
    }
    PG8_WAIT_V(0);
    if constexpr (!ALIGN_EPI) { if (wr == 0) PG8_BAR; }
    PG8_BAR;
    if constexpr (Epi::AFTER_DRAIN) { E.fused(acc, cur, wr, wc, fr, fq, lds, wid, lane); S.done(cur); }
#undef PG8_SA
#undef PG8_SB
#undef PG8_STAGE
#undef PG8_LDA
#undef PG8_LDB
#undef PG8_MMA
#undef PG8_WAIT_V
#undef PG8_WAIT_L
#undef PG8_BAR
#undef PG8_SCHED
#undef PG8_UA
#undef PG8_UB
}
}
namespace pg8 {
__device__ __forceinline__ float sigmoid_fast(float x) { return __builtin_amdgcn_rcpf(1.0f + __builtin_amdgcn_exp2f(-1.4426950408889634f * x)); }
__device__ __forceinline__ float bf_lo(unsigned w) { return __builtin_bit_cast(float, w << 16); }
__device__ __forceinline__ float bf_hi(unsigned w) { return __builtin_bit_cast(float, w & 0xffff0000u); }
struct EpiStore {
    static constexpr bool PERM = true, AFTER_DRAIN = false;
    bf16_t* O; int ldc; const float* bias;
    __device__ __forceinline__ void operator()(const f32x4 (&acc)[2][2][4][2], const Unit& u, int wr, int wc, int fr, int fq) const {
        const int row0 = u.pm * BM + wr * 64 + fr, col0 = u.pn * BM + wc * 32 + 8 * fq;
        f32x4 bv[2][2];
#pragma unroll
        for (int bj = 0; bj < 2; ++bj)
#pragma unroll
            for (int n = 0; n < 2; ++n) bv[bj][n] = bias ? *(const f32x4*)(bias + col0 + bj * HALF + 4 * n) : (f32x4){0.f, 0.f, 0.f, 0.f};
#pragma unroll
        for (int ai = 0; ai < 2; ++ai)
#pragma unroll
            for (int m = 0; m < 4; ++m) { bf16_t* rowp = O + (size_t)(row0 + ai * HALF + m * 16) * ldc + col0;
#pragma unroll
                for (int bj = 0; bj < 2; ++bj) { const f32x4 v0 = acc[ai][bj][m][0] + bv[bj][0], v1 = acc[ai][bj][m][1] + bv[bj][1];
                    u32x4 w; w.x = cvt_pk_bf16(v0[0], v0[1]); w.y = cvt_pk_bf16(v0[2], v0[3]); w.z = cvt_pk_bf16(v1[0], v1[1]); w.w = cvt_pk_bf16(v1[2], v1[3]);
                    *(u32x4*)(rowp + bj * HALF) = w; } }
    }
};
struct EpiSwiGLU {
    static constexpr bool PERM = true, AFTER_DRAIN = false;
    bf16_t* O; int ldc;
    __device__ __forceinline__ void operator()(const f32x4 (&acc)[2][2][4][2], const Unit& u, int wr, int wc, int fr, int fq) const {
        const int row0 = u.pm * BM + wr * 64 + fr, col0 = u.pn * HALF + wc * 32 + 8 * fq;
#pragma unroll
        for (int ai = 0; ai < 2; ++ai)
#pragma unroll
            for (int m = 0; m < 4; ++m) { bf16_t* rowp = O + (size_t)(row0 + ai * HALF + m * 16) * ldc + col0;
                float r[8];
#pragma unroll
                for (int n = 0; n < 2; ++n)
#pragma unroll
                    for (int e = 0; e < 4; ++e) { const float a = acc[ai][0][m][n][e], b = acc[ai][1][m][n][e]; r[4 * n + e] = a * sigmoid_fast(a) * b; }
                u32x4 w; w.x = cvt_pk_bf16(r[0], r[1]); w.y = cvt_pk_bf16(r[2], r[3]); w.z = cvt_pk_bf16(r[4], r[5]); w.w = cvt_pk_bf16(r[6], r[7]);
                *(u32x4*)rowp = w; }
    }
};
struct EpiGLU {
    static constexpr bool PERM = true, AFTER_DRAIN = false;
    bf16_t* O; int ldc; const bf16_t* Y; int ldy; const float* bias;
    __device__ __forceinline__ void operator()(const f32x4 (&acc)[2][2][4][2], const Unit& u, int wr, int wc, int fr, int fq) const {
        const int row0 = u.pm * BM + wr * 64 + fr, col0 = u.pn * BM + wc * 32 + 8 * fq;
        f32x4 bv[2][2];
#pragma unroll
        for (int bj = 0; bj < 2; ++bj)
#pragma unroll
            for (int n = 0; n < 2; ++n) bv[bj][n] = *(const f32x4*)(bias + col0 + bj * HALF + 4 * n);
#pragma unroll
        for (int ai = 0; ai < 2; ++ai)
#pragma unroll
            for (int m = 0; m < 4; ++m) { const size_t r = (size_t)(row0 + ai * HALF + m * 16);
#pragma unroll
                for (int bj = 0; bj < 2; ++bj) { const u32x4 yw = *(const u32x4*)(Y + r * ldy + col0 + bj * HALF);
                    const f32x4 v0 = acc[ai][bj][m][0] + bv[bj][0], v1 = acc[ai][bj][m][1] + bv[bj][1];
                    u32x4 w; w.x = cvt_pk_bf16(bf_lo(yw.x) * sigmoid_fast(v0[0]), bf_hi(yw.x) * sigmoid_fast(v0[1])); w.y = cvt_pk_bf16(bf_lo(yw.y) * sigmoid_fast(v0[2]), bf_hi(yw.y) * sigmoid_fast(v0[3]));
                    w.z = cvt_pk_bf16(bf_lo(yw.z) * sigmoid_fast(v1[0]), bf_hi(yw.z) * sigmoid_fast(v1[1])); w.w = cvt_pk_bf16(bf_lo(yw.w) * sigmoid_fast(v1[2]), bf_hi(yw.w) * sigmoid_fast(v1[3]));
                    *(u32x4*)(O + r * ldc + col0 + bj * HALF) = w; } }
    }
};
struct EpiGate {
    static constexpr bool PERM = true, AFTER_DRAIN = false;
    bf16_t* O; int ldc; const bf16_t* L; int ldl;
    __device__ __forceinline__ void operator()(const f32x4 (&acc)[2][2][4][2], const Unit& u, int wr, int wc, int fr, int fq) const {
        const int row0 = u.pm * BM + wr * 64 + fr, col0 = u.pn * BM + wc * 32 + 8 * fq;
#pragma unroll
        for (int ai = 0; ai < 2; ++ai)
#pragma unroll
            for (int m = 0; m < 4; ++m) { const size_t r = (size_t)(row0 + ai * HALF + m * 16);
#pragma unroll
                for (int bj = 0; bj < 2; ++bj) { const u32x4 lw = *(const u32x4*)(L + r * ldl + col0 + bj * HALF);
                    const f32x4 v0 = acc[ai][bj][m][0], v1 = acc[ai][bj][m][1];
                    u32x4 w; w.x = cvt_pk_bf16(v0[0] * sigmoid_fast(bf_lo(lw.x)), v0[1] * sigmoid_fast(bf_hi(lw.x))); w.y = cvt_pk_bf16(v0[2] * sigmoid_fast(bf_lo(lw.y)), v0[3] * sigmoid_fast(bf_hi(lw.y)));
                    w.z = cvt_pk_bf16(v1[0] * sigmoid_fast(bf_lo(lw.z)), v1[1] * sigmoid_fast(bf_hi(lw.z))); w.w = cvt_pk_bf16(v1[2] * sigmoid_fast(bf_lo(lw.w)), v1[3] * sigmoid_fast(bf_hi(lw.w)));
                    *(u32x4*)(O + r * ldc + col0 + bj * HALF) = w; } }
    }
};
}
#define GAS __attribute__((address_space(1)))
#define LAS __attribute__((address_space(3)))
typedef unsigned short bf16;
typedef unsigned v4u __attribute__((ext_vector_type(4)));
typedef float f32x4 __attribute__((ext_vector_type(4)));
typedef short bf16x8 __attribute__((ext_vector_type(8)));
typedef GAS unsigned gu32;
typedef GAS unsigned long long gu64;
#define RLX_AGENT __ATOMIC_RELAXED, __HIP_MEMORY_SCOPE_AGENT
#define LDS_WAIT() asm volatile("s_waitcnt lgkmcnt(0)" ::: "memory")
#define VM_WAIT() asm volatile("s_waitcnt vmcnt(0)" ::: "memory")
__device__ __forceinline__ unsigned long long rt() { return __builtin_amdgcn_s_memrealtime(); }
__device__ __forceinline__ unsigned f2bf(float f) { unsigned u = __builtin_bit_cast(unsigned, f); return (u + 0x7fffu + ((u >> 16) & 1u)) >> 16; }
__device__ __forceinline__ unsigned pk2(float lo, float hi) { return f2bf(lo) | (f2bf(hi) << 16); }

#define XB_TMO      128
#define XB_XCNT(j)  (256  + 64 * (j))
#define XB_XSUB(j)  (1280 + 64 * (j))
#define XB_XGEN(j)  (2304 + 64 * (j))
#define XB_TOP      3328
#define XB_TOPGEN   3392
#define XCD_BAR_WORDS 3456
#define XB_SPIN_CAP (1u << 22)

__device__ __forceinline__ unsigned xb_ld(unsigned* p)              { return __hip_atomic_load(p, __ATOMIC_RELAXED, __HIP_MEMORY_SCOPE_AGENT); }
__device__ __forceinline__ unsigned xb_add(unsigned* p, unsigned v) { return __hip_atomic_fetch_add(p, v, __ATOMIC_RELAXED, __HIP_MEMORY_SCOPE_AGENT); }
__device__ __forceinline__ unsigned xb_xcc_id() { return (unsigned)__builtin_amdgcn_s_getreg((3 << 11) | 20) & 0xFu; }
#define XB_SPIN(cond, bar) do { unsigned _sp = 0; while (cond) { __builtin_amdgcn_s_sleep(1); \
    if ((++_sp & 255u) == 0u) { if (xb_ld(&(bar)[XB_TMO])) break; if (_sp > XB_SPIN_CAP) { atomicAdd(&(bar)[XB_TMO], 1u); break; } } } } while (0)

struct XcdBarrier {
    unsigned* bar; unsigned x;
    volatile LAS unsigned* st;
};

__device__ __forceinline__ XcdBarrier xcd_barrier_post(unsigned* bar, volatile LAS unsigned* st) {
    XcdBarrier b; b.bar = bar; b.x = xb_xcc_id(); b.st = st;
    if (threadIdx.x == 0) (void)xb_add(&bar[XB_XCNT(b.x)], 1u);
    return b;
}
__device__ __forceinline__ void xcd_barrier_complete(unsigned* bar, unsigned x, unsigned& nloc, unsigned& nx) {
    const unsigned G = gridDim.x * gridDim.y * gridDim.z;
    unsigned sum, cnt, mine, sp = 0u;
    for (;;) {
        sum = 0u; cnt = 0u; mine = 0u;
#pragma unroll
        for (unsigned j = 0; j < 16; ++j) { const unsigned c = xb_ld(&bar[XB_XCNT(j)]); sum += c; cnt += (c > 0u) ? 1u : 0u; mine = (j == x) ? c : mine; }
        if (sum == G) break;
        __builtin_amdgcn_s_sleep(1);
        if ((++sp & 255u) == 0u) { if (xb_ld(&bar[XB_TMO])) break; if (sp > XB_SPIN_CAP) { atomicAdd(&bar[XB_TMO], 1u); break; } }
    }
    nloc = mine > 0u ? mine : 1u; nx = cnt > 0u ? cnt : 1u;
}

__device__ __forceinline__ void xcd_barrier(const XcdBarrier& b) {
    asm volatile("s_waitcnt vmcnt(0)" ::: "memory");
    __syncthreads();
    if (threadIdx.x == 0) {
        unsigned* bar = b.bar;
        __builtin_amdgcn_s_waitcnt(0);
        unsigned nloc = b.st[0], nx = b.st[1];
        if (nloc == 0u) { xcd_barrier_complete(bar, b.x, nloc, nx); b.st[0] = nloc; b.st[1] = nx; }
        const unsigned old = xb_add(&bar[XB_XSUB(b.x)], 1u);
        const unsigned gen = old / nloc;
        if (old + 1u == (gen + 1u) * nloc) {
            __builtin_amdgcn_fence(__ATOMIC_RELEASE, "agent");
            asm volatile("s_waitcnt vmcnt(0)" ::: "memory");
            const unsigned og = xb_add(&bar[XB_TOP], 1u);
            const unsigned tg = og / nx;
            if (og + 1u == (tg + 1u) * nx) xb_add(&bar[XB_TOPGEN], 1u);
            else XB_SPIN(xb_ld(&bar[XB_TOPGEN]) == tg, bar);
            __builtin_amdgcn_fence(__ATOMIC_ACQUIRE, "agent");
            xb_add(&bar[XB_XGEN(b.x)], 1u);
            asm volatile("s_waitcnt vmcnt(0)" ::: "memory");
        } else {
            XB_SPIN(xb_ld(&bar[XB_XGEN(b.x)]) == gen, bar);
            __builtin_amdgcn_fence(__ATOMIC_ACQUIRE, "agent");
            asm volatile("s_waitcnt vmcnt(0)" ::: "memory");
        }
    }
    __syncthreads();
}

constexpr int NWAVES = 8;
constexpr int DM = 1024, NBATCH = 16, SEQ = 4096, DEPTH = 4, DFF = 2816, MALL = NBATCH * SEQ;
constexpr int NIN = 8864, NINP = 8960;
constexpr int C_QA = 0, C_KVA = 384, C_KR = 640, C_DIL = 672, C_U = 5280, C_GATE = 5792;
constexpr int QR = 384, KVR = 256;
constexpr int CHB = 4, CHROWS = CHB * SEQ, NCHUNK = NBATCH / CHB;
constexpr float LN_EPS = 1e-5f, RMS_EPS = 1e-6f;
constexpr float DN_ALPHA = 1.681792830507429f;
constexpr float LOG2E = 1.4426950408889634f;

constexpr size_t MiB = 1u << 20;
constexpr size_t WS_CTL = 0, CTL_ZERO_BYTES = 1 * MiB;
constexpr size_t WS_ADA = 1 * MiB;
constexpr size_t WS_SMALL = 4 * MiB;
constexpr size_t SM_BIAS = 0, SM_LAM = 64 * 1024, SM_BRE = 128 * 1024, SM_BIM = 256 * 1024 + 128 * 1024, SM_CRE = 640 * 1024, SM_CIM = 896 * 1024;
constexpr size_t WS_W = 6 * MiB;
constexpr size_t W_13 = 0, W_13_SZ = (size_t)2 * DFF * DM * 2;
constexpr size_t W_2 = W_13 + 2 * W_13_SZ, W_2_SZ = (size_t)DM * DFF * 2;
constexpr size_t W_IN = W_2 + 2 * W_2_SZ, W_IN_SZ = (size_t)NINP * DM * 2;
constexpr size_t W_QB = W_IN + W_IN_SZ, W_QB_SZ = (size_t)768 * QR * 2;
constexpr size_t W_KVB = W_QB + W_QB_SZ, W_KVB_SZ = (size_t)1024 * KVR * 2;
constexpr size_t W_GLU = W_KVB + W_KVB_SZ, W_GLU_SZ = (size_t)512 * 512 * 2;
constexpr size_t W_BR = W_GLU + W_GLU_SZ, W_BR_SZ = (size_t)3072 * 512 * 2;
constexpr size_t W_OUT = W_BR + W_BR_SZ, W_OUT_SZ = (size_t)1024 * 3072 * 2;
constexpr size_t W_END = W_OUT + W_OUT_SZ;
static_assert(W_END <= 64 * MiB, "weights region");
constexpr size_t WS_HM = 70 * MiB;
constexpr size_t WS_F = 198 * MiB;
constexpr size_t WS_BIG = 326 * MiB;
constexpr size_t WS_G = WS_BIG;
constexpr size_t WS_PROJ = WS_BIG;
constexpr size_t WS_QRAW = WS_BIG + 280 * MiB;
constexpr size_t WS_KVRAW = WS_QRAW + 24 * MiB;
constexpr size_t WS_QF = WS_KVRAW + 32 * MiB;
constexpr size_t WS_KF = WS_QF + 24 * MiB;
constexpr size_t WS_VF = WS_KF + 24 * MiB;
constexpr size_t WS_YS = WS_VF + 16 * MiB;
constexpr size_t WS_Y3 = WS_YS + 16 * MiB;
constexpr size_t WS_OG = WS_Y3 + 48 * MiB;
constexpr size_t WS_LSE = WS_OG + 48 * MiB;
constexpr size_t WS_T = WS_LSE + 1 * MiB;
constexpr size_t WS_END = WS_T + 96 * MiB;
static_assert(WS_END <= 1024 * MiB && WS_G + (size_t)MALL * DFF * 2 <= 1024 * MiB, "d_ws map");
constexpr int CW_BAR = 4096;

constexpr int RING_OFF = 0, RING_BYTES = 131072;
constexpr int LDSCTL_OFF = RING_BYTES, MISC_OFF = LDSCTL_OFF + 320;
constexpr int LDS_BYTES = 147456;

typedef unsigned v2u __attribute__((ext_vector_type(2)));
struct Frame {
    LAS unsigned char* lds;
    int tid, lane, wave, G, bid;
};
struct Args { const void* in[28]; float* out; unsigned char* ws; int ph_lo, ph_hi; };

__device__ __forceinline__ float wave_sum(float v) {
#pragma unroll
    for (int o = 1; o < 64; o <<= 1) v += __shfl_xor(v, o);
    return v;
}
__device__ __forceinline__ float bf2f(unsigned short h) { return __builtin_bit_cast(float, (unsigned)h << 16); }
__device__ __forceinline__ float bflo(unsigned w) { return __builtin_bit_cast(float, w << 16); }
__device__ __forceinline__ float bfhi(unsigned w) { return __builtin_bit_cast(float, w & 0xffff0000u); }

__device__ __forceinline__ void phase_ada(Frame& F, const float* cvec, const float* w_ada, const float* b_ada, float* ada) {
    LAS float* cond = (LAS float*)(F.lds);
    LAS float* red = (LAS float*)(F.lds + 65536);
    for (int u = F.bid; u < DEPTH * 72; u += F.G) {
        const int l = u / 72, n0 = (u % 72) * 128;
        for (int i = F.tid; i < NBATCH * DM; i += NWAVES * 64) { const float c = cvec[i]; cond[i] = c / (1.0f + __expf(-c)); }
        __syncthreads();
        const int kq = F.tid >> 7, nn = F.tid & 127;
        float acc[16];
#pragma unroll
        for (int b = 0; b < 16; ++b) acc[b] = 0.f;
        const float* wp = w_ada + ((size_t)l * DM + kq * 256) * 9216 + n0 + nn;
#pragma unroll 4
        for (int k = 0; k < 256; ++k) { const float w = wp[(size_t)k * 9216];
#pragma unroll
            for (int b = 0; b < 16; ++b) acc[b] += cond[b * DM + kq * 256 + k] * w; }
#pragma unroll
        for (int b = 0; b < 16; ++b) red[(kq * 16 + b) * 128 + nn] = acc[b];
        __syncthreads();
#pragma unroll
        for (int i = 0; i < 4; ++i) { const int idx = F.tid + 512 * i, b = idx >> 7, n = idx & 127;
            const float v = red[(0 * 16 + b) * 128 + n] + red[(1 * 16 + b) * 128 + n] + red[(2 * 16 + b) * 128 + n] + red[(3 * 16 + b) * 128 + n] + b_ada[(size_t)l * 9216 + n0 + n];
            ada[((size_t)l * 16 + b) * 9216 + n0 + n] = v; }
        __syncthreads();
    }
}

__device__ __forceinline__ void conv_item(const float* W, int N, bf16* dst, int pitch, int koff, int mode, int hi, const float* kscale, LAS float* scr, int item, int lane, int ncopy) {
    const int nblk = N / 32, kb = item / nblk, nb = item % nblk, k0 = 64 * kb, n0 = 32 * nb;
#pragma unroll 8
    for (int i = 0; i < 32; ++i) { const int kk = 2 * i + (lane >> 5); float v = W[(size_t)(k0 + kk) * N + n0 + (lane & 31)]; if (kscale) v *= kscale[k0 + kk]; scr[kk * 33 + (lane & 31)] = v; }
    LDS_WAIT(); asm volatile("" ::: "memory");
    const int c = lane & 7;
    const int r0 = (mode == 0) ? n0 : ((n0 >> 7) * 256 + (n0 & 127) + (hi ? 128 : 0));
#pragma unroll
    for (int j = 0; j < 4; ++j) { const int n = (lane >> 3) + 8 * j; const LAS float* s = scr + (8 * c) * 33 + n;
        v4u o; o.x = pk2(s[0 * 33], s[1 * 33]); o.y = pk2(s[2 * 33], s[3 * 33]); o.z = pk2(s[4 * 33], s[5 * 33]); o.w = pk2(s[6 * 33], s[7 * 33]);
        for (int cp = 0; cp < ncopy; ++cp) *(GAS v4u*)(dst + (size_t)(r0 + n) * pitch + koff + cp * 1024 + k0 + 8 * c) = o; }
    LDS_WAIT(); asm volatile("" ::: "memory");
}
__device__ __forceinline__ void conv_job(Frame& F, const float* W, int K, int N, bf16* dst, int pitch, int mode, int hi, const float* kscale, int ncopy) {
    LAS float* scr = (LAS float*)(F.lds + RING_OFF + F.wave * 16384);
    const int gw = F.bid * NWAVES + F.wave, NGW = F.G * NWAVES, nitems = (K / 64) * (N / 32);
    for (int it = gw; it < nitems; it += NGW) conv_item(W, N, dst, pitch, 0, mode, hi, kscale, scr, it, F.lane, ncopy);
}
__device__ __forceinline__ void phase_wconv(Frame& F, const Args& A, int l) {
    unsigned char* ws = A.ws; bf16* wb = (bf16*)(ws + WS_W);
#pragma nounroll
    for (int jj = 0; jj < 14; ++jj) {
        int j = jj; asm volatile("" : "+s"(j));
        const float* src; int K, N, pitch, mode = 0, hi = 0, ncopy = 1; size_t dsto; const float* ksc = nullptr;
        if (j < 6) { const int s = j / 3, t = j - 3 * s; const size_t o13 = ((size_t)l * 2 + s) * DM * DFF;
            if (t == 0) { src = (const float*)A.in[7] + o13; K = DM; N = DFF; pitch = DM; mode = 1; hi = 0; dsto = W_13 + s * W_13_SZ; }
            else if (t == 1) { src = (const float*)A.in[8] + o13; K = DM; N = DFF; pitch = DM; mode = 1; hi = 1; dsto = W_13 + s * W_13_SZ; }
            else { src = (const float*)A.in[9] + o13; K = DFF; N = DM; pitch = DFF; dsto = W_2 + s * W_2_SZ; } }
        else if (j == 6) { src = (const float*)A.in[10] + (size_t)l * DM * NIN; K = DM; N = NIN; pitch = DM; dsto = W_IN; }
        else if (j == 7) { src = (const float*)A.in[14] + (size_t)l * QR * 768; K = QR; N = 768; pitch = QR; dsto = W_QB; ksc = (const float*)A.in[12] + l * QR; }
        else if (j == 8) { src = (const float*)A.in[15] + (size_t)l * KVR * 1024; K = KVR; N = 1024; pitch = KVR; dsto = W_KVB; ksc = (const float*)A.in[13] + l * KVR; }
        else if (j == 9) { src = (const float*)A.in[24] + (size_t)l * 512 * 512; K = 512; N = 512; pitch = 512; dsto = W_GLU; }
        else if (j < 13) { const int i = j - 10; src = (const float*)A.in[26] + ((size_t)l * 3 + i) * 512 * 1024; K = 512; N = 1024; pitch = 512; dsto = W_BR + (size_t)i * 1024 * 512 * 2; }
        else { src = (const float*)A.in[27] + (size_t)l * DM * DM; K = DM; N = DM; pitch = 3072; dsto = W_OUT; ncopy = 3; }
        conv_job(F, src, K, N, (bf16*)((unsigned char*)wb + dsto), pitch, mode, hi, ksc, ncopy);
    }
    const int gt = F.bid * (NWAVES * 64) + F.tid, NT = F.G * NWAVES * 64;
    { GAS v4u* z = (GAS v4u*)((unsigned char*)wb + W_IN + (size_t)NIN * DM * 2); const int nz = (NINP - NIN) * DM * 2 / 16;
      unsigned zz = 0u; asm volatile("" : "+v"(zz));
      for (int i = gt; i < nz; i += NT) z[i] = (v4u){zz, zz, zz, zz}; }
    { float* bp = (float*)(ws + WS_SMALL + SM_BIAS); const float* bin = (const float*)A.in[11] + (size_t)l * NIN;
      for (int i = gt; i < NINP; i += NT) bp[i] = (i < NIN) ? bin[i] : 0.f; }
    { const float* lre = (const float*)A.in[16] + l * 2048; const float* lim = (const float*)A.in[17] + l * 2048; const float* ldt = (const float*)A.in[18] + l * 32;
      const float* bre = (const float*)A.in[19] + (size_t)l * 32768; const float* bim = (const float*)A.in[20] + (size_t)l * 32768;
      const float* cre = (const float*)A.in[21] + (size_t)l * 32768; const float* cim = (const float*)A.in[22] + (size_t)l * 32768;
      float* tl = (float*)(ws + WS_SMALL + SM_LAM); float* tbr = (float*)(ws + WS_SMALL + SM_BRE); float* tbi = (float*)(ws + WS_SMALL + SM_BIM);
      float* tcr = (float*)(ws + WS_SMALL + SM_CRE); float* tci = (float*)(ws + WS_SMALL + SM_CIM);
      for (int i = gt; i < 2048; i += NT) { const int g = i >> 6, p = i & 63;
          const float dt = expf(ldt[g]), lr = lre[i], li = lim[i], zr = lr * dt, zi = li * dt;
          const float e = expf(zr), cz = cosf(zi), sz = sinf(zi), sh = sinf(0.5f * zi);
          const float nr = expm1f(zr) * cz - 2.0f * sh * sh, ni = e * sz;
          const float den = 1.0f / (lr * lr + li * li), qr = (nr * lr + ni * li) * den, qi = (ni * lr - nr * li) * den;
          tl[2 * i] = e * cz; tl[2 * i + 1] = e * sz;
          for (int h = 0; h < 16; ++h) { const float br = bre[(size_t)i * 16 + h], bi = bim[(size_t)i * 16 + h];
              tbr[(size_t)i * 16 + h] = qr * br - qi * bi; tbi[(size_t)i * 16 + h] = qr * bi + qi * br; }
          for (int k = 0; k < 16; ++k) { tcr[(size_t)i * 16 + k] = cre[((size_t)g * 16 + k) * 64 + p]; tci[(size_t)i * 16 + k] = cim[((size_t)g * 16 + k) * 64 + p]; }
      } }
}

__device__ __forceinline__ void phase_lnmod(Frame& F, bool do_ln, const float* hin, const bf16* Fs, float* hout, bf16* hm, int row0, int nrows,
                                            const float* ada_gate  , float rw, const float* lng, const float* lnb, const float* ada_next  ) {
    const int gw = F.bid * NWAVES + F.wave, NGW = F.G * NWAVES, rpw = nrows / NGW;
    const int r_begin = row0 + gw * rpw, b = r_begin / SEQ, lane = F.lane;
    f32x4 ga[4], lg[4], lb[4], sc[4], sh[4];
#pragma unroll
    for (int j = 0; j < 4; ++j) { const int c = 4 * lane + 256 * j;
        if (do_ln) { ga[j] = *(const f32x4*)(ada_gate + (size_t)b * 9216 + c) * rw; lg[j] = *(const f32x4*)(lng + c); lb[j] = *(const f32x4*)(lnb + c); }
        else { ga[j] = (f32x4){0.f, 0.f, 0.f, 0.f}; lg[j] = ga[j]; lb[j] = ga[j]; }
        if (hm) { sh[j] = *(const f32x4*)(ada_next + (size_t)b * 9216 + c); sc[j] = *(const f32x4*)(ada_next + (size_t)b * 9216 + 1024 + c) + 1.0f; }
        else { sh[j] = (f32x4){0.f, 0.f, 0.f, 0.f}; sc[j] = sh[j]; } }
    for (int r = 0; r < rpw; ++r) {
        const size_t row = (size_t)(r_begin + r);
        f32x4 v[4];
#pragma unroll
        for (int j = 0; j < 4; ++j) v[j] = *(const GAS f32x4*)(hin + row * DM + 4 * lane + 256 * j);
        if (do_ln) {
            float s = 0.f;
#pragma unroll
            for (int j = 0; j < 4; ++j) { const v2u fw = *(const GAS v2u*)(Fs + (row - row0) * DM + 4 * lane + 256 * j);
                const f32x4 f = (f32x4){bflo(fw.x), bfhi(fw.x), bflo(fw.y), bfhi(fw.y)};
                v[j] = v[j] * DN_ALPHA + ga[j] * f; s += (v[j].x + v[j].y) + (v[j].z + v[j].w); }
            const float mean = wave_sum(s) * (1.f / DM); float s2 = 0.f;
#pragma unroll
            for (int j = 0; j < 4; ++j) { v[j] = v[j] - mean; s2 += (v[j].x * v[j].x + v[j].y * v[j].y) + (v[j].z * v[j].z + v[j].w * v[j].w); }
            const float rstd = 1.f / sqrtf(wave_sum(s2) * (1.f / DM) + LN_EPS);
#pragma unroll
            for (int j = 0; j < 4; ++j) { v[j] = v[j] * rstd * lg[j] + lb[j]; *(GAS f32x4*)(hout + row * DM + 4 * lane + 256 * j) = v[j]; }
        }
        if (hm) {
#pragma unroll
            for (int j = 0; j < 4; ++j) { const f32x4 o = v[j] * sc[j] + sh[j]; v2u w; w.x = pk2(o.x, o.y); w.y = pk2(o.z, o.w);
                *(GAS v2u*)(hm + row * DM + 4 * lane + 256 * j) = w; }
        }
    }
}

__device__ __forceinline__ void phase_prep(Frame& F, const bf16* proj, const bf16* qraw, const bf16* kvraw, const int* positions, int tok0, bf16* qf, bf16* kf, bf16* vf) {
    const int gw = F.bid * NWAVES + F.wave, NGW = F.G * NWAVES, lane = F.lane;
    const float SC = 0.10206207261596575f * LOG2E;
    const float inv_freq = exp2f(-(float)(lane & 15) * (13.287712379549449f / 16.0f));
    for (int row = gw; row < CHROWS; row += NGW) {
        const bf16* pr = proj + (size_t)row * NINP; const bf16* qr = qraw + (size_t)row * 768; const bf16* kr = kvraw + (size_t)row * 1024;
        float sq = 0.f, sk = 0.f;
#pragma unroll
        for (int i = 0; i < 6; ++i) { const float v = bf2f(pr[C_QA + lane + 64 * i]); sq += v * v; }
#pragma unroll
        for (int i = 0; i < 4; ++i) { const float v = bf2f(pr[C_KVA + lane + 64 * i]); sk += v * v; }
        const float rq = rsqrtf(wave_sum(sq) * (1.f / QR) + RMS_EPS) * SC, rk = rsqrtf(wave_sum(sk) * (1.f / KVR) + RMS_EPS);
        const float ang = (float)positions[tok0 + row] * inv_freq; const float cs = cosf(ang), sn = sinf(ang);
#pragma unroll
        for (int i = 0; i < 12; ++i) { const int e = lane + 64 * i, h = e / 96, r = e - 96 * h; const int rr = (r >= 64) ? r - 64 : 0, j = rr & 15, up = rr >> 4;
            const float c = __shfl(cs, j), s = __shfl(sn, j);
            float vq, vk;
            if (r < 64) { vq = bf2f(qr[e]); vk = bf2f(kr[h * 128 + r]) * rk; }
            else { const float t1 = bf2f(qr[h * 96 + 64 + j]), t2 = bf2f(qr[h * 96 + 80 + j]); vq = up ? (t2 * c + t1 * s) : (t1 * c - t2 * s);
                   const float k1 = bf2f(pr[C_KR + j]), k2 = bf2f(pr[C_KR + 16 + j]); vk = up ? (k2 * c + k1 * s) : (k1 * c - k2 * s); }
            qf[(size_t)row * 768 + e] = (bf16)f2bf(vq * rq); kf[(size_t)row * 768 + e] = (bf16)f2bf(vk); }
#pragma unroll
        for (int i = 0; i < 8; ++i) { const int e = lane + 64 * i, h = e >> 6, r = e & 63; vf[(size_t)row * 512 + e] = (bf16)f2bf(bf2f(kr[h * 128 + 64 + r]) * rk); }
    }
}

__device__ __forceinline__ void phase_dilmerge(Frame& F, const bf16* og, const float* lse2, bf16* ydil) {
    const int gw = F.bid * NWAVES + F.wave, NGW = F.G * NWAVES, lane = F.lane, slot = lane >> 4;
    for (int row = gw; row < CHROWS; row += NGW) {
        float l0 = lse2[(size_t)0 * CHROWS * 4 + (size_t)row * 4 + slot], l1 = lse2[(size_t)1 * CHROWS * 4 + (size_t)row * 4 + slot], l2 = lse2[(size_t)2 * CHROWS * 4 + (size_t)row * 4 + slot];
        const float mx = fmaxf(l0, fmaxf(l1, l2)); float w0 = exp2f(l0 - mx), w1 = exp2f(l1 - mx), w2 = exp2f(l2 - mx); const float inv = 1.0f / (w0 + w1 + w2); w0 *= inv; w1 *= inv; w2 *= inv;
        const v4u a = *(const GAS v4u*)(og + (size_t)0 * CHROWS * 512 + (size_t)row * 512 + 8 * lane), b = *(const GAS v4u*)(og + (size_t)1 * CHROWS * 512 + (size_t)row * 512 + 8 * lane), c = *(const GAS v4u*)(og + (size_t)2 * CHROWS * 512 + (size_t)row * 512 + 8 * lane);
        v4u o;
        o.x = pk2(w0 * bflo(a.x) + w1 * bflo(b.x) + w2 * bflo(c.x), w0 * bfhi(a.x) + w1 * bfhi(b.x) + w2 * bfhi(c.x));
        o.y = pk2(w0 * bflo(a.y) + w1 * bflo(b.y) + w2 * bflo(c.y), w0 * bfhi(a.y) + w1 * bfhi(b.y) + w2 * bfhi(c.y));
        o.z = pk2(w0 * bflo(a.z) + w1 * bflo(b.z) + w2 * bflo(c.z), w0 * bfhi(a.z) + w1 * bfhi(b.z) + w2 * bfhi(c.z));
        o.w = pk2(w0 * bflo(a.w) + w1 * bflo(b.w) + w2 * bflo(c.w), w0 * bfhi(a.w) + w1 * bfhi(b.w) + w2 * bfhi(c.w));
        *(GAS v4u*)(ydil + (size_t)row * 512 + 8 * lane) = o;
    }
}

template <int DK, int DV>
__device__ __forceinline__ void attn_unit_ref(Frame& F, const bf16* Qp, const bf16* Kp, long rs, const bf16* Vp, long rs_v, bf16* Op, long rs_o, float* Lp, long rs_l,
                                              int qpos0, int klo, int khi, int band, float scale2, float slope2) {
    constexpr int DKP = DK / 4, DVP = DV / 4;
    LAS unsigned char* Ks = F.lds;
    LAS unsigned char* Vs = F.lds + 64 * DK * 2;
    const int tid = F.tid, part = tid & 3, qi = tid >> 2, qpos = qpos0 + qi;
    float qv[DKP], ov[DVP];
#pragma unroll
    for (int e8 = 0; e8 < DKP / 8; ++e8) { const v4u w = *(const GAS v4u*)(Qp + (long)qpos * rs + part * DKP + e8 * 8);
        qv[e8 * 8 + 0] = bflo(w.x); qv[e8 * 8 + 1] = bfhi(w.x); qv[e8 * 8 + 2] = bflo(w.y); qv[e8 * 8 + 3] = bfhi(w.y);
        qv[e8 * 8 + 4] = bflo(w.z); qv[e8 * 8 + 5] = bfhi(w.z); qv[e8 * 8 + 6] = bflo(w.w); qv[e8 * 8 + 7] = bfhi(w.w); }
#pragma unroll
    for (int e = 0; e < DVP; ++e) ov[e] = 0.f;
    float m = -1e30f, l = 0.f;
    for (int kt = klo; kt < khi; kt += 64) {
        for (int c = tid; c < 64 * DK / 8; c += NWAVES * 64) { const int j = c / (DK / 8), cc = c % (DK / 8); const int kp = kt + j;
            v4u w = (v4u){0u, 0u, 0u, 0u}; if (kp >= 0) w = *(const GAS v4u*)(Kp + (long)kp * rs + cc * 8);
            *(LAS v4u*)(Ks + (j * DK + cc * 8) * 2) = w; }
        for (int c = tid; c < 64 * DV / 8; c += NWAVES * 64) { const int j = c / (DV / 8), cc = c % (DV / 8); const int kp = kt + j;
            v4u w = (v4u){0u, 0u, 0u, 0u}; if (kp >= 0) w = *(const GAS v4u*)(Vp + (long)kp * rs_v + cc * 8);
            *(LAS v4u*)(Vs + (j * DV + cc * 8) * 2) = w; }
        __syncthreads();
        for (int j = 0; j < 64; ++j) {
            const int kp = kt + j, dist = qpos - kp;
            float d = 0.f;
#pragma unroll
            for (int e8 = 0; e8 < DKP / 8; ++e8) { const v4u w = *(const LAS v4u*)(Ks + (j * DK + part * DKP + e8 * 8) * 2);
                d += qv[e8 * 8 + 0] * bflo(w.x) + qv[e8 * 8 + 1] * bfhi(w.x) + qv[e8 * 8 + 2] * bflo(w.y) + qv[e8 * 8 + 3] * bfhi(w.y)
                   + qv[e8 * 8 + 4] * bflo(w.z) + qv[e8 * 8 + 5] * bfhi(w.z) + qv[e8 * 8 + 6] * bflo(w.w) + qv[e8 * 8 + 7] * bfhi(w.w); }
            d += __shfl_xor(d, 1); d += __shfl_xor(d, 2);
            const bool valid = (kp >= 0) && (dist >= 0) && (dist <= band);
            if (valid) {
                const float s = d * scale2 - slope2 * (float)dist;
                const float mn = fmaxf(m, s), a = exp2f(m - mn), p = exp2f(s - mn);
                l = l * a + p; m = mn;
#pragma unroll
                for (int e8 = 0; e8 < DVP / 8; ++e8) { const v4u w = *(const LAS v4u*)(Vs + (j * DV + part * DVP + e8 * 8) * 2);
                    ov[e8 * 8 + 0] = ov[e8 * 8 + 0] * a + p * bflo(w.x); ov[e8 * 8 + 1] = ov[e8 * 8 + 1] * a + p * bfhi(w.x);
                    ov[e8 * 8 + 2] = ov[e8 * 8 + 2] * a + p * bflo(w.y); ov[e8 * 8 + 3] = ov[e8 * 8 + 3] * a + p * bfhi(w.y);
                    ov[e8 * 8 + 4] = ov[e8 * 8 + 4] * a + p * bflo(w.z); ov[e8 * 8 + 5] = ov[e8 * 8 + 5] * a + p * bfhi(w.z);
                    ov[e8 * 8 + 6] = ov[e8 * 8 + 6] * a + p * bflo(w.w); ov[e8 * 8 + 7] = ov[e8 * 8 + 7] * a + p * bfhi(w.w); }
            }
        }
        __syncthreads();
    }
    const float inv = 1.0f / l;
#pragma unroll
    for (int e8 = 0; e8 < DVP / 8; ++e8) { v4u w; w.x = pk2(ov[e8 * 8 + 0] * inv, ov[e8 * 8 + 1] * inv); w.y = pk2(ov[e8 * 8 + 2] * inv, ov[e8 * 8 + 3] * inv);
        w.z = pk2(ov[e8 * 8 + 4] * inv, ov[e8 * 8 + 5] * inv); w.w = pk2(ov[e8 * 8 + 6] * inv, ov[e8 * 8 + 7] * inv);
        *(GAS v4u*)(Op + (long)qpos * rs_o + part * DVP + e8 * 8) = w; }
    if (Lp && part == 0) Lp[(long)qpos * rs_l] = m + log2f(l);
}

__device__ __forceinline__ void phase_dilated_ref(Frame& F, const bf16* proj, bf16* og, float* lse2) {
    for (int u = F.bid; u < CHB * 3 * 4 * 32; u += F.G) {
        const int jq = u & 31, hh = (u >> 5) & 3, g = (u >> 7) % 3, b = u / 384;
        const int d = (g == 0) ? 1 : (g == 1) ? 4 : 16, bpr = 32 / d, r = jq / bpr, j = jq % bpr;
        const int head = g * 4 + hh;
        const float slope = exp2f(-8.0f * (float)(head + 1) / 12.0f);
        const bf16* Qp = proj + ((size_t)b * SEQ + r) * NINP + C_DIL + head * 128;
        bf16* Op = og + (size_t)g * CHROWS * 512 + ((size_t)b * SEQ + r) * 512 + hh * 128;
        float* Lp = lse2 + (size_t)g * CHROWS * 4 + ((size_t)b * SEQ + r) * 4 + hh;
        attn_unit_ref<128, 128>(F, Qp, Qp + 1536, (long)NINP * d, Qp + 3072, (long)NINP * d, Op, 512L * d, Lp, 4L * d,
                                128 * j, 128 * j - 128, 128 * j + 128, 128, 0.08838834764831845f * LOG2E, slope * (float)d * LOG2E);
    }
}
__device__ __forceinline__ void phase_mla_ref(Frame& F, const bf16* qf, const bf16* kf, const bf16* vf, bf16* ymla) {
    const int nun = CHB * 8 * 32;
    for (int i = 0; F.bid + i * F.G < nun; ++i) {
        int bh, jb;
        if (F.G == 256) { const int s = F.bid & 7; bh = F.bid >> 3; jb = (i == 0) ? s : (i == 1) ? 15 - s : (i == 2) ? 16 + s : 31 - s; }
        else { const int t = F.bid + i * F.G; bh = t >> 5; jb = t & 31; }
        const int b = bh >> 3, h = bh & 7;
        attn_unit_ref<96, 64>(F, qf + (size_t)b * SEQ * 768 + h * 96, kf + (size_t)b * SEQ * 768 + h * 96, 768L, vf + (size_t)b * SEQ * 512 + h * 64, 512L,
                              ymla + (size_t)b * SEQ * 512 + h * 64, 512L, nullptr, 0L, 128 * jb, 0, 128 * jb + 128, 1 << 30, 1.0f, 0.0f);
    }
}

__device__ __forceinline__ float gelu_tanh(float x) { const float t = 0.7978845608028654f * (x + 0.044715f * x * x * x); const float e = __expf(2.0f * t); const float th = 1.0f - 2.0f / (e + 1.0f); return 0.5f * x * (1.0f + th); }
__device__ __forceinline__ void phase_ssm_ref(Frame& F, const bf16* proj, const float* tabs  , const float* dskip  , bf16* ys) {
    const int lane = F.lane;
    const float* tl = (const float*)((const unsigned char*)tabs + SM_LAM); const float* tbr = (const float*)((const unsigned char*)tabs + SM_BRE); const float* tbi = (const float*)((const unsigned char*)tabs + SM_BIM);
    const float* tcr = (const float*)((const unsigned char*)tabs + SM_CRE); const float* tci = (const float*)((const unsigned char*)tabs + SM_CIM);
    for (int u = F.bid + F.wave * F.G; u < CHB * 32; u += F.G * NWAVES) {
        const int b = u >> 5, g = u & 31, i = g * 64 + lane;
        const float lr = tl[2 * i], li = tl[2 * i + 1];
        float br[16], bi[16], cr[16], ci[16];
#pragma unroll
        for (int h = 0; h < 16; ++h) { br[h] = tbr[(size_t)i * 16 + h]; bi[h] = tbi[(size_t)i * 16 + h]; cr[h] = tcr[(size_t)i * 16 + h]; ci[h] = tci[(size_t)i * 16 + h]; }
        const float dk = dskip[g * 16 + (lane & 15)];
        float xr = 0.f, xi = 0.f;
        const bf16* up = proj + (size_t)b * SEQ * NINP + C_U + g * 16; bf16* yp = ys + (size_t)b * SEQ * 512 + g * 16;
        for (int t0 = 0; t0 < SEQ; t0 += 4) {
            v4u ua[4], ub[4];
#pragma unroll
            for (int tt = 0; tt < 4; ++tt) { ua[tt] = *(const GAS v4u*)(up + (size_t)(t0 + tt) * NINP); ub[tt] = *(const GAS v4u*)(up + (size_t)(t0 + tt) * NINP + 8); }
#pragma unroll
            for (int tt = 0; tt < 4; ++tt) {
                float uu[16];
                uu[0] = bflo(ua[tt].x); uu[1] = bfhi(ua[tt].x); uu[2] = bflo(ua[tt].y); uu[3] = bfhi(ua[tt].y); uu[4] = bflo(ua[tt].z); uu[5] = bfhi(ua[tt].z); uu[6] = bflo(ua[tt].w); uu[7] = bfhi(ua[tt].w);
                uu[8] = bflo(ub[tt].x); uu[9] = bfhi(ub[tt].x); uu[10] = bflo(ub[tt].y); uu[11] = bfhi(ub[tt].y); uu[12] = bflo(ub[tt].z); uu[13] = bfhi(ub[tt].z); uu[14] = bflo(ub[tt].w); uu[15] = bfhi(ub[tt].w);
                float pr = 0.f, pi = 0.f;
#pragma unroll
                for (int h = 0; h < 16; ++h) { pr += br[h] * uu[h]; pi += bi[h] * uu[h]; }
                const float nxr = lr * xr - li * xi + pr, nxi = lr * xi + li * xr + pi; xr = nxr; xi = nxi;
                float my = 0.f, myu = 0.f;
#pragma unroll
                for (int k = 0; k < 16; ++k) { const float yk = wave_sum(cr[k] * xr - ci[k] * xi); if ((lane & 15) == k) { my = yk; myu = uu[k]; } }
                const float y = my + dk * myu;
                if (lane < 16) yp[(size_t)(t0 + tt) * 512 + lane] = (bf16)f2bf(gelu_tanh(y));
            }
        }
    }
}

#ifndef MK_MULTI
#define MK_MULTI 0
#endif
constexpr int NPHASES = 2 + DEPTH * (3 + NCHUNK * 7 + 3) + (DEPTH - 1);

__global__ void __launch_bounds__(NWAVES * 64, 2) fwd_kernel(Args args) {
    extern __shared__ __attribute__((aligned(16))) unsigned char lds[];
    Frame F;
    F.lds = (LAS unsigned char*)lds;
    F.tid = threadIdx.x; F.lane = F.tid & 63; F.wave = __builtin_amdgcn_readfirstlane(F.tid >> 6);
    F.G = 256; F.bid = blockIdx.x;
    unsigned char* ws = args.ws;
    gu32* ctl = (gu32*)(ws + WS_CTL);
    for (int u = F.tid; u < (LDS_BYTES - LDSCTL_OFF) / 4; u += NWAVES * 64) ((LAS unsigned*)(F.lds + LDSCTL_OFF))[u] = 0u;
    __syncthreads();
    (void)xcd_barrier_post((unsigned*)(ctl + CW_BAR), (volatile LAS unsigned*)(F.lds + MISC_OFF) + 8);
#define GRID_BAR() do { size_t zofb_ = 0; asm volatile("" : "+s"(zofb_)); unsigned char* wsb = args.ws + zofb_; XcdBarrier bar_; bar_.bar = (unsigned*)(wsb + WS_CTL) + CW_BAR; bar_.x = xb_xcc_id(); bar_.st = (volatile LAS unsigned*)(F.lds + MISC_OFF) + 8; xcd_barrier(bar_); } while (0)
#if MK_MULTI
    const int lo = args.ph_lo, hi = args.ph_hi;
    int pc = 0;
#define SITE_BEGIN if (pc >= lo && pc < hi) { size_t zoff_ = 0; asm volatile("" : "+s"(zoff_)); unsigned char* wsl = args.ws + zoff_; F.tid = threadIdx.x; asm volatile("" : "+v"(F.tid)); F.lane = F.tid & 63;
#define SITE_END } ++pc;
#else
#define SITE_BEGIN { size_t zoff_ = 0; asm volatile("" : "+s"(zoff_)); unsigned char* wsl = args.ws + zoff_; F.tid = threadIdx.x; asm volatile("" : "+v"(F.tid)); F.lane = F.tid & 63;
#define SITE_END } GRID_BAR();
#endif

#define x_in ((const float*)args.in[0])
#define positions ((const int*)args.in[2])
#define ada ((float*)(wsl + WS_ADA))
#define h (args.out)
#define hm ((bf16*)(wsl + WS_HM))
#define Fs ((bf16*)(wsl + WS_F))
#define gbuf ((bf16*)(wsl + WS_G))
#define proj ((bf16*)(wsl + WS_PROJ))
#define qraw ((bf16*)(wsl + WS_QRAW))
#define kvraw ((bf16*)(wsl + WS_KVRAW))
#define qf ((bf16*)(wsl + WS_QF))
#define kf ((bf16*)(wsl + WS_KF))
#define vf ((bf16*)(wsl + WS_VF))
#define ys ((bf16*)(wsl + WS_YS))
#define y3 ((bf16*)(wsl + WS_Y3))
#define og ((bf16*)(wsl + WS_OG))
#define lse2 ((float*)(wsl + WS_LSE))
#define tb ((bf16*)(wsl + WS_T))
#define wb ((const unsigned char*)(wsl + WS_W))
#define lng_all ((const float*)args.in[5])
#define lnb_all ((const float*)args.in[6])
#define ada_l (ada + (size_t)l * 16 * 9216)
    for (int l = 0; l < DEPTH; ++l) {
        SITE_BEGIN
#ifndef SKIP_ADA
            if (l == 0) phase_ada(F, (const float*)args.in[1], (const float*)args.in[3], (const float*)args.in[4], ada);
#endif
#ifndef SKIP_WCONV
            phase_wconv(F, args, l);
#endif
        SITE_END
        if (l == 0) {
            SITE_BEGIN
                phase_lnmod(F, false, x_in, nullptr, nullptr, hm, 0, MALL, nullptr, 0.f, nullptr, nullptr, ada + 0);
            SITE_END
        }
        for (int half = 0; half < 2; ++half) {
            const int s = half * 2;
            SITE_BEGIN
                pg8::Gemm g{hm, (const bf16*)(wb + W_13 + half * W_13_SZ), MALL, 2 * DFF, DM, DM, DM, 0, 0};
                pg8::StaticOrder S; S.init(MALL, 2 * DFF, F.G, F.bid);
                pg8::EpiSwiGLU E{gbuf, DFF};
                pg8::gemm_phase<pg8::EpiSwiGLU, pg8::StaticOrder, true, true>(F.lds + RING_OFF, g, S, E);
            SITE_END
            SITE_BEGIN
                pg8::Gemm g{gbuf, (const bf16*)(wb + W_2 + half * W_2_SZ), MALL, DM, DFF, DFF, DFF, 0, 0};
                pg8::StaticOrder S; S.init(MALL, DM, F.G, F.bid);
                pg8::EpiStore E{Fs, DM, nullptr};
                pg8::gemm_phase<pg8::EpiStore, pg8::StaticOrder, true, true>(F.lds + RING_OFF, g, S, E);
            SITE_END
            SITE_BEGIN
                const bool last = (l == DEPTH - 1) && (half == 1);
                const float* hin = (l == 0 && half == 0) ? x_in : h;
                const float* ada_next = (half == 0) ? ada_l + 1 * 3072 : ada_l + (size_t)16 * 9216 + 0;
                phase_lnmod(F, true, hin, Fs, h, last ? nullptr : hm, 0, MALL, ada_l + s * 3072 + 2048, 0.5f, lng_all + ((size_t)l * 3 + s) * DM, lnb_all + ((size_t)l * 3 + s) * DM, ada_next);
            SITE_END
            if (half == 1) break;
            for (int c = 0; c < NCHUNK; ++c) {
                const int tok0 = c * CHROWS;
                SITE_BEGIN
                    pg8::Gemm g{hm + (size_t)tok0 * DM, (const bf16*)(wb + W_IN), CHROWS, NINP, DM, DM, DM, 0, 0};
                    pg8::StaticOrder S; S.init(CHROWS, NINP, F.G, F.bid);
                    pg8::EpiStore E{proj, NINP, (const float*)(wsl + WS_SMALL + SM_BIAS)};
                    pg8::gemm_phase<pg8::EpiStore, pg8::StaticOrder, true, true>(F.lds + RING_OFF, g, S, E);
                SITE_END
                SITE_BEGIN
                    { pg8::Gemm g{proj + C_QA, (const bf16*)(wb + W_QB), CHROWS, 768, QR, NINP, QR, 0, 0};
                      pg8::StaticOrder S; S.init(CHROWS, 768, F.G, F.bid);
                      pg8::EpiStore E{qraw, 768, nullptr};
                      pg8::gemm_phase<pg8::EpiStore, pg8::StaticOrder, true, true>(F.lds + RING_OFF, g, S, E); }
                    { pg8::Gemm g{proj + C_KVA, (const bf16*)(wb + W_KVB), CHROWS, 1024, KVR, NINP, KVR, 0, 0};
                      pg8::StaticOrder S; S.init(CHROWS, 1024, F.G, F.bid);
                      pg8::EpiStore E{kvraw, 1024, nullptr};
                      pg8::gemm_phase<pg8::EpiStore, pg8::StaticOrder, true, true>(F.lds + RING_OFF, g, S, E); }
                    __syncthreads();
#ifndef SKIP_DIL
                    phase_dilated_ref(F, proj, og, lse2);
#endif
#ifndef SKIP_SSM
                    phase_ssm_ref(F, proj, (const float*)(wsl + WS_SMALL), (const float*)args.in[23] + l * 512, ys);
#endif
                SITE_END
                SITE_BEGIN
#ifndef SKIP_PREP
                    phase_prep(F, proj, qraw, kvraw, positions, tok0, qf, kf, vf);
#endif
                    phase_dilmerge(F, og, lse2, y3 + (size_t)1 * CHROWS * 512);
                    { pg8::Gemm g{ys, (const bf16*)(wb + W_GLU), CHROWS, 512, 512, 512, 512, 0, 0};
                      pg8::StaticOrder S; S.init(CHROWS, 512, F.G, F.bid);
                      pg8::EpiGLU E{y3 + (size_t)2 * CHROWS * 512, 512, ys, 512, (const float*)args.in[25] + l * 512};
                      pg8::gemm_phase<pg8::EpiGLU, pg8::StaticOrder, true, true>(F.lds + RING_OFF, g, S, E); }
                SITE_END
                SITE_BEGIN
#ifndef SKIP_MLA
                    phase_mla_ref(F, qf, kf, vf, y3);
#endif
                SITE_END
                SITE_BEGIN
                    pg8::Gemm g{y3, (const bf16*)(wb + W_BR), CHROWS, 3072, 512, 512, 512, 4, (long)CHROWS * 512};
                    pg8::StaticOrder S; S.init(CHROWS, 3072, F.G, F.bid);
                    pg8::EpiGate E{tb, 3072, proj + C_GATE, NINP};
                    pg8::gemm_phase<pg8::EpiGate, pg8::StaticOrder, true, true>(F.lds + RING_OFF, g, S, E);
                SITE_END
                SITE_BEGIN
                    pg8::Gemm g{tb, (const bf16*)(wb + W_OUT), CHROWS, DM, 3072, 3072, 3072, 0, 0};
                    pg8::StaticOrder S; S.init(CHROWS, DM, F.G, F.bid);
                    pg8::EpiStore E{Fs, DM, nullptr};
                    pg8::gemm_phase<pg8::EpiStore, pg8::StaticOrder, true, true>(F.lds + RING_OFF, g, S, E);
                SITE_END
                SITE_BEGIN
                    phase_lnmod(F, true, h, Fs, h, hm, tok0, CHROWS, ada_l + 1 * 3072 + 2048, 1.0f, lng_all + ((size_t)l * 3 + 1) * DM, lnb_all + ((size_t)l * 3 + 1) * DM, ada_l + 2 * 3072);
                SITE_END
            }
        }
    }
#undef SITE_BEGIN
#undef SITE_END
#undef x_in
#undef positions
#undef ada
#undef h
#undef hm
#undef Fs
#undef gbuf
#undef proj
#undef qraw
#undef kvraw
#undef qf
#undef kf
#undef vf
#undef ys
#undef y3
#undef og
#undef lse2
#undef tb
#undef wb
#undef lng_all
#undef lnb_all
#undef ada_l
}

extern "C" void kernel_launch(void* const* d_in, const int* in_sizes, int n_in, void* d_out, int out_size, void* d_ws, size_t ws_size, hipStream_t stream) {
    static int grid = 0;
    if (grid == 0) {
        if (n_in != 28 || in_sizes[0] != MALL * DM || out_size != MALL * DM || ws_size < WS_END || ws_size < WS_G + (size_t)MALL * DFF * 2) {
            fprintf(stderr, "kernel_launch: unexpected problem shape (n_in %d, in0 %d, out %d, ws %zu); nothing launched\n", n_in, n_in > 0 ? in_sizes[0] : -1, out_size, ws_size); grid = -1; return; }
        int dev = 0, cus = 0, per_cu = 0;
        if (hipGetDevice(&dev) != hipSuccess || hipDeviceGetAttribute(&cus, hipDeviceAttributeMultiprocessorCount, dev) != hipSuccess) { grid = -1; return; }
        if (hipFuncSetAttribute((const void*)fwd_kernel, hipFuncAttributeMaxDynamicSharedMemorySize, LDS_BYTES) != hipSuccess) { fprintf(stderr, "kernel_launch: hipFuncSetAttribute failed\n"); grid = -1; return; }
        if (hipOccupancyMaxActiveBlocksPerMultiprocessor(&per_cu, (const void*)fwd_kernel, NWAVES * 64, LDS_BYTES) != hipSuccess || per_cu < 1)
            fprintf(stderr, "kernel_launch: note: occupancy query reports %d workgroups per CU\n", per_cu);
        (void)hipGetLastError();
        grid = cus;
        if (grid != 256) { fprintf(stderr, "kernel_launch: built for a 256-CU device, found %d CUs; nothing launched\n", cus); grid = -1; return; }
    }
    if (grid < 0) return;
    if (hipMemsetAsync((char*)d_ws + WS_CTL, 0, CTL_ZERO_BYTES, stream) != hipSuccess) return;
    Args a{};
    for (int i = 0; i < 28; ++i) a.in[i] = d_in[i];
    a.out = (float*)d_out; a.ws = (unsigned char*)d_ws;
#if MK_MULTI
    for (int p = 0; p < NPHASES; ++p) { a.ph_lo = p; a.ph_hi = p + 1; hipLaunchKernelGGL(fwd_kernel, dim3(grid), dim3(NWAVES * 64), LDS_BYTES, stream, a); }
#else
    a.ph_lo = 0; a.ph_hi = NPHASES;
    hipLaunchKernelGGL(fwd_kernel, dim3(grid), dim3(NWAVES * 64), LDS_BYTES, stream, a);
#endif
    const hipError_t le = hipPeekAtLastError();
    if (le != hipSuccess) fprintf(stderr, "kernel_launch: launch failed: %s\n", hipGetErrorName(le));
}
```

```cpp
#include <hip/hip_runtime.h>
#include <cstdio>
#include <cstdint>
#include <cmath>
namespace pg8 {
#define PG8_LAS __attribute__((address_space(3)))
typedef unsigned short bf16_t;
typedef short bf16x8 __attribute__((ext_vector_type(8)));
typedef float f32x4 __attribute__((ext_vector_type(4)));
typedef unsigned u32x4 __attribute__((ext_vector_type(4)));
constexpr int BM = 256, BK = 64, HALF = 128, HTB = HALF * BK * 2  , STAGE_BYTES = 8 * HTB, NXCD = 8, WGM = 8;

__host__ __device__ __forceinline__ int lds_byte(int r, int c) { const int st = (r >> 4) * 2 + (c >> 5), rr = r & 15, cc = c & 31, ob = rr * 64 + cc * 2; return st * 1024 + (ob ^ (((ob >> 9) & 1) << 5)); }
__host__ __device__ __forceinline__ void stage_rc(int b, int& R, int& C) { const int st = b / 1024, sb = b % 1024, swz = sb ^ (((sb >> 9) & 1) << 5); R = (st >> 1) * 16 + swz / 64; C = (st & 1) * 32 + (swz % 64) / 2; }
__host__ __device__ __forceinline__ int perm32(int rho) { const int n = rho >> 4, i = rho & 15; return 8 * (i >> 2) + 4 * n + (i & 3); }

struct Unit { int pm, pn; };
struct Gemm { const bf16_t* A; const bf16_t* Bt; int M, N, K; int lda, ldb; int asplit; long astride; int bsplit; long bstride; };

struct StaticOrder {
    int nM, nN, nwg, G, c;
    __host__ __device__ void init(int M, int N, int G_, int c_) { nM = M / BM; nN = N / BM; nwg = nM * nN; G = G_; c = c_; }
    __host__ __device__ bool next(int i, Unit& u) const {
        const long L = (long)i * G + c; if (L >= nwg) return false;
        int wgid = (int)L; { const int q = nwg / NXCD, r = nwg % NXCD, xcd = wgid % NXCD, off = wgid / NXCD; wgid = (xcd < r ? xcd * (q + 1) : r * (q + 1) + (xcd - r) * q) + off; }
        const int nig = WGM * nN, gid = wgid / nig, fm = gid * WGM, gsz = (nM - fm) < WGM ? (nM - fm) : WGM;
        u.pm = fm + ((wgid % nig) % gsz); u.pn = (wgid % nig) / gsz; return true;
    }
    __device__ __forceinline__ void a_ready(const Unit&) const {}
    __device__ __forceinline__ void done(const Unit&) const {}
};

__device__ __forceinline__ unsigned cvt_pk_bf16(float lo, float hi) { unsigned r; asm volatile("v_cvt_pk_bf16_f32 %0, %1, %2" : "=v"(r) : "v"(lo), "v"(hi)); return r; }
typedef float f32x2 __attribute__((ext_vector_type(2)));
__device__ __forceinline__ f32x2 gelu_pk(f32x2 v) {
    const f32x2 av = __builtin_elementwise_abs(v), d = av * 0.2316418882f + 1.0f;
    f32x2 t; t.x = __builtin_amdgcn_rcpf(d.x); t.y = __builtin_amdgcn_rcpf(d.y);
    f32x2 q = t * 0.5307027145f + (-0.7265760135f); q = q * t + 0.7107068705f; q = q * t + (-0.142248368f); q = q * t + 0.127414796f; q = q * t;
    const f32x2 s = (v * v) * (-0.72134752044f);
    f32x2 e; e.x = __builtin_amdgcn_exp2f(s.x); e.y = __builtin_amdgcn_exp2f(s.y);
    const f32x2 m = v * (q * e), r = v - m;
    f32x2 o; o.x = v.x < 0.f ? m.x : r.x; o.y = v.y < 0.f ? m.y : r.y; return o;
}

template <int ACT  > struct EpiBf16 {
    static constexpr bool PERM = true, AFTER_DRAIN = false; static_assert(ACT == 0 || ACT == 1, "EpiBf16: ACT is 0 (none) or 1 (gelu_pk)");
    bf16_t* O; int ldc; const float* bias; int split_cols; size_t split_stride; float scale0;
    __device__ __forceinline__ void operator()(const f32x4 (&acc)[2][2][4][2], const Unit& u, int wr, int wc, int fr, int fq) const {
        const int row0 = u.pm * BM + wr * 64 + fr; int colt = u.pn * BM; bf16_t* base = O;
        float sc = 1.f; if (split_cols) { const int t = colt / split_cols; base += (size_t)t * split_stride; colt -= t * split_cols; if (t == 0) sc = scale0; }
        const int col0 = colt + wc * 32 + 8 * fq, bcol0 = u.pn * BM + wc * 32 + 8 * fq;
        f32x4 bv[2][2];
#pragma unroll
        for (int bj = 0; bj < 2; ++bj)
#pragma unroll
            for (int n = 0; n < 2; ++n) bv[bj][n] = bias ? *(const f32x4*)(bias + bcol0 + bj * HALF + 4 * n) : (f32x4){0.f, 0.f, 0.f, 0.f};
#pragma unroll
        for (int ai = 0; ai < 2; ++ai)
#pragma unroll
            for (int m = 0; m < 4; ++m) { bf16_t* rowp = base + (size_t)(row0 + ai * HALF + m * 16) * ldc + col0;
#pragma unroll
                for (int bj = 0; bj < 2; ++bj) { f32x4 v0 = acc[ai][bj][m][0] + bv[bj][0], v1 = acc[ai][bj][m][1] + bv[bj][1];
                    if (ACT == 1) { f32x2 a = gelu_pk((f32x2){v0[0], v0[1]}), b = gelu_pk((f32x2){v0[2], v0[3]}), c = gelu_pk((f32x2){v1[0], v1[1]}), d = gelu_pk((f32x2){v1[2], v1[3]});
                        v0 = (f32x4){a.x, a.y, b.x, b.y}; v1 = (f32x4){c.x, c.y, d.x, d.y}; }
                    v0 = v0 * sc; v1 = v1 * sc; u32x4 w; w.x = cvt_pk_bf16(v0[0], v0[1]); w.y = cvt_pk_bf16(v0[2], v0[3]); w.z = cvt_pk_bf16(v1[0], v1[1]); w.w = cvt_pk_bf16(v1[2], v1[3]);
                    *(u32x4*)(rowp + bj * HALF) = w; } }
    }
};

struct PanelStats {
    unsigned* xbuf;
    unsigned* cnt;
    unsigned* tmo;
    int ntn; float eps;
    unsigned code;
    __device__ __forceinline__ bool run(const f32x4 (&v)[2][2][4][2], const Unit& u, int wr, int wc, int fr, int fq, PG8_LAS unsigned char* lds, int wid, int lane) const {
        typedef float f32x2v __attribute__((ext_vector_type(2)));
        PG8_LAS f32x2v* P = (PG8_LAS f32x2v*)lds;
        PG8_LAS f32x2v* S = (PG8_LAS f32x2v*)(lds + 8192);
        PG8_LAS unsigned* flag = (PG8_LAS unsigned*)(lds + 8192 + 2048);
#pragma unroll
        for (int ai = 0; ai < 2; ++ai)
#pragma unroll
            for (int m = 0; m < 4; ++m) {
                float s = 0.f;
#pragma unroll
                for (int bj = 0; bj < 2; ++bj)
#pragma unroll
                    for (int n = 0; n < 2; ++n) { const f32x4 x = v[ai][bj][m][n]; s += (x[0] + x[1]) + (x[2] + x[3]); }
                s += __shfl_xor(s, 16); s += __shfl_xor(s, 32);
                const float mw = s * (1.0f / 64.0f); float q = 0.f;
#pragma unroll
                for (int bj = 0; bj < 2; ++bj)
#pragma unroll
                    for (int n = 0; n < 2; ++n) { const f32x4 d = v[ai][bj][m][n] - mw; q += (d[0] * d[0] + d[1] * d[1]) + (d[2] * d[2] + d[3] * d[3]); }
                q += __shfl_xor(q, 16); q += __shfl_xor(q, 32);
                if (fq == 0) P[(ai * HALF + wr * 64 + m * 16 + fr) * 4 + wc] = (f32x2v){mw, q};
            }
        asm volatile("s_waitcnt lgkmcnt(0)" ::: "memory"); __builtin_amdgcn_s_barrier(); asm volatile("" ::: "memory");
#if defined(BROKEN_EXCHANGE_NO_WAIT)
#warning BROKEN CONTROL BUILD: the row-statistics exchange does not wait; results are wrong by design
        if (blockIdx.x >= 64) { const long long t0_ = clock64(); while (clock64() - t0_ < 60000) __builtin_amdgcn_s_sleep(8); }
#endif
        const int row = wid * 32 + (lane & 31);
        if (lane < 32) {
            const f32x2v a = P[row * 4 + 0], b = P[row * 4 + 1], c = P[row * 4 + 2], d = P[row * 4 + 3];
            const float mt = (a.x + b.x + c.x + d.x) * 0.25f;
            const float da = a.x - mt, db = b.x - mt, dc = c.x - mt, dd = d.x - mt;
            const float m2 = (a.y + b.y) + (c.y + d.y) + 64.0f * ((da * da + db * db) + (dc * dc + dd * dd));
            unsigned long long* slot = (unsigned long long*)xbuf + ((size_t)(u.pm * BM + row) * 4 + u.pn);
            __hip_atomic_store(slot, ((unsigned long long)__float_as_uint(m2) << 32) | __float_as_uint(mt), __ATOMIC_RELAXED, __HIP_MEMORY_SCOPE_AGENT);
        }
        asm volatile("s_waitcnt vmcnt(0)" ::: "memory");
        if (lane == 0) __hip_atomic_fetch_add(cnt + 64 * u.pm, 1u, __ATOMIC_RELAXED, __HIP_MEMORY_SCOPE_AGENT);
        if (wid == 0) {
            bool dead = false; const unsigned long long t0 = __builtin_amdgcn_s_memrealtime(); const unsigned want = 8u * (unsigned)ntn;
            for (;;) {
#if defined(BROKEN_EXCHANGE_NO_WAIT)
                break;
#endif
                if ((unsigned)__builtin_amdgcn_readfirstlane(__hip_atomic_load(cnt + 64 * u.pm, __ATOMIC_RELAXED, __HIP_MEMORY_SCOPE_AGENT)) >= want) break;
                if (__builtin_amdgcn_s_memrealtime() - t0 > 2000000ull) {
                    if (lane == 0) { unsigned expect = 0u; __hip_atomic_compare_exchange_strong(tmo + 1, &expect, code | (unsigned)(u.pm & 0xff), __ATOMIC_RELAXED, __ATOMIC_RELAXED, __HIP_MEMORY_SCOPE_AGENT);
                                     __hip_atomic_store(tmo, 1u, __ATOMIC_RELAXED, __HIP_MEMORY_SCOPE_AGENT); }
                    dead = true; break; }
                __builtin_amdgcn_s_sleep(2);
            }
            __builtin_amdgcn_fence(__ATOMIC_ACQUIRE, "agent");
            if (lane == 0) flag[0] = dead ? 1u : 0u;
        }
        asm volatile("s_waitcnt vmcnt(0) lgkmcnt(0)" ::: "memory"); __builtin_amdgcn_s_barrier(); asm volatile("" ::: "memory");
        const bool bad = flag[0] != 0u;
        if (lane < 32) {
            const unsigned long long* slot = (const unsigned long long*)xbuf + (size_t)(u.pm * BM + row) * 4; float mt[4], m2[4]; float ms = 0.f;
#pragma unroll
            for (int t = 0; t < 4; ++t) { if (t < ntn) { const unsigned long long w = __hip_atomic_load(slot + t, __ATOMIC_RELAXED, __HIP_MEMORY_SCOPE_AGENT); mt[t] = __uint_as_float((unsigned)w); m2[t] = __uint_as_float((unsigned)(w >> 32)); } else { mt[t] = 0.f; m2[t] = 0.f; } ms += mt[t]; }
            const float mean = ms / (float)ntn; float q = 0.f;
#pragma unroll
            for (int t = 0; t < 4; ++t) if (t < ntn) { const float dm = mt[t] - mean; q += m2[t] + 256.0f * dm * dm; }
            S[row] = (f32x2v){mean, 1.0f / sqrtf(q / (256.0f * (float)ntn) + eps)};
        }
        asm volatile("s_waitcnt lgkmcnt(0)" ::: "memory"); __builtin_amdgcn_s_barrier(); asm volatile("" ::: "memory");
        return bad;
    }
};
struct EpiLnRes {
    static constexpr bool PERM = false, AFTER_DRAIN = true;
    const float* base; float* out; int ldc; const float* bias; PanelStats st; unsigned poison;
    __device__ __forceinline__ void fused(f32x4 (&acc)[2][2][4][2], const Unit& u, int wr, int wc, int fr, int fq, PG8_LAS unsigned char* lds, int wid, int lane) const {
        typedef float f32x2v __attribute__((ext_vector_type(2)));
        const PG8_LAS f32x2v* S = (const PG8_LAS f32x2v*)(lds + 8192);
        const int col0 = u.pn * BM + wc * 32 + 4 * fq;
#pragma unroll
        for (int bj = 0; bj < 2; ++bj)
#pragma unroll
            for (int n = 0; n < 2; ++n) { const f32x4 bv = bias ? *(const f32x4*)(bias + col0 + bj * HALF + n * 16) : (f32x4){0.f, 0.f, 0.f, 0.f};
#pragma unroll
                for (int ai = 0; ai < 2; ++ai)
#pragma unroll
                    for (int m = 0; m < 4; ++m) acc[ai][bj][m][n] += bv; }
        f32x4 pre[4][2][2];
#pragma unroll
        for (int m = 0; m < 4; ++m) { const size_t off = (size_t)(u.pm * BM + wr * 64 + m * 16 + fr) * ldc + col0;
#pragma unroll
            for (int bj = 0; bj < 2; ++bj)
#pragma unroll
                for (int n = 0; n < 2; ++n) pre[m][bj][n] = *(const f32x4*)(base + off + bj * HALF + n * 16); }
        const bool bad = st.run(acc, u, wr, wc, fr, fq, lds, wid, lane) || poison != 0u;
        const float qnan = __builtin_nanf("");
#pragma unroll
        for (int ai = 0; ai < 2; ++ai)
#pragma unroll
            for (int m = 0; m < 4; ++m) { const int r = ai * HALF + wr * 64 + m * 16 + fr; const f32x2v sr = S[r]; const size_t off = (size_t)(u.pm * BM + r) * ldc + col0;
#pragma unroll
                for (int bj = 0; bj < 2; ++bj)
#pragma unroll
                    for (int n = 0; n < 2; ++n) { const f32x4 bs = ai == 0 ? pre[m][bj][n] : *(const f32x4*)(base + off + bj * HALF + n * 16); f32x4 o = bs + (acc[ai][bj][m][n] - sr.x) * sr.y;
                        if (bad) o = (f32x4){qnan, qnan, qnan, qnan}; *(f32x4*)(out + off + bj * HALF + n * 16) = o; }
                if (m & 1) asm volatile("" ::: "memory"); }
    }
};
struct EpiLnResLn {
    static constexpr bool PERM = false, AFTER_DRAIN = true;
    const float* base; float* out; bf16_t* xn; int ldc; const float* bias; PanelStats st1, st2; unsigned poison;
    __device__ __forceinline__ void fused(f32x4 (&acc)[2][2][4][2], const Unit& u, int wr, int wc, int fr, int fq, PG8_LAS unsigned char* lds, int wid, int lane) const {
        typedef float f32x2v __attribute__((ext_vector_type(2))); typedef unsigned u32x2v __attribute__((ext_vector_type(2)));
        const PG8_LAS f32x2v* S = (const PG8_LAS f32x2v*)(lds + 8192);
        const int col0 = u.pn * BM + wc * 32 + 4 * fq;
#pragma unroll
        for (int bj = 0; bj < 2; ++bj)
#pragma unroll
            for (int n = 0; n < 2; ++n) { const f32x4 bv = bias ? *(const f32x4*)(bias + col0 + bj * HALF + n * 16) : (f32x4){0.f, 0.f, 0.f, 0.f};
#pragma unroll
                for (int ai = 0; ai < 2; ++ai)
#pragma unroll
                    for (int m = 0; m < 4; ++m) acc[ai][bj][m][n] += bv; }
        bool bad = st1.run(acc, u, wr, wc, fr, fq, lds, wid, lane) || poison != 0u;
        const float qnan = __builtin_nanf("");
#pragma unroll
        for (int ai = 0; ai < 2; ++ai)
#pragma unroll
            for (int m = 0; m < 4; ++m) { const int r = ai * HALF + wr * 64 + m * 16 + fr; const f32x2v sr = S[r]; const size_t off = (size_t)(u.pm * BM + r) * ldc + col0;
#pragma unroll
                for (int bj = 0; bj < 2; ++bj)
#pragma unroll
                    for (int n = 0; n < 2; ++n) { const f32x4 bs = *(const f32x4*)(base + off + bj * HALF + n * 16); acc[ai][bj][m][n] = bs + (acc[ai][bj][m][n] - sr.x) * sr.y; }
                asm volatile("" : "+v"(acc[ai][0][m][0]), "+v"(acc[ai][0][m][1]), "+v"(acc[ai][1][m][0]), "+v"(acc[ai][1][m][1]));
                if (m & 1) asm volatile("" ::: "memory"); }
        const bool bad1 = bad;
        bad = st2.run(acc, u, wr, wc, fr, fq, lds, wid, lane) || bad;
#pragma unroll
        for (int ai = 0; ai < 2; ++ai)
#pragma unroll
            for (int m = 0; m < 4; ++m) { const int r = ai * HALF + wr * 64 + m * 16 + fr; const f32x2v sr = S[r]; const size_t off = (size_t)(u.pm * BM + r) * ldc + col0;
#pragma unroll
                for (int bj = 0; bj < 2; ++bj)
#pragma unroll
                    for (int n = 0; n < 2; ++n) { const f32x4 x1 = acc[ai][bj][m][n]; *(f32x4*)(out + off + bj * HALF + n * 16) = bad1 ? (f32x4){qnan, qnan, qnan, qnan} : x1;
                        const f32x4 o = (x1 - sr.x) * sr.y; u32x2v w; w.x = cvt_pk_bf16(o[0], o[1]); w.y = cvt_pk_bf16(o[2], o[3]);
                        if (bad) { w.x = 0x7fc07fc0u; w.y = 0x7fc07fc0u; } *(u32x2v*)(xn + off + bj * HALF + n * 16) = w; }
                asm volatile("" ::: "memory"); }
    }
};

template <class Epi, class Sched, bool ALIGN_EPI = false, bool SP2 = false>
__device__ __forceinline__ void gemm_phase(PG8_LAS unsigned char* lds, const Gemm g, const Sched& S, const Epi& E, int tid_in) {
    int tid_ = tid_in; asm volatile("" : "+v"(tid_));
    const int tid = tid_, wid = __builtin_amdgcn_readfirstlane(tid >> 6), lane = tid & 63, wr = wid >> 2, wc = wid & 3, fr = lane & 15, fq = lane >> 4;
    const int K = g.K, nt = K / BK;
    unsigned voffA[2], voffB[2];
#pragma unroll
    for (int i = 0; i < 2; ++i) { int R, C; stage_rc(tid * 16 + i * 8192, R, C); const int Rb = Epi::PERM ? ((R & ~31) + perm32(R & 31)) : R;
        voffA[i] = (unsigned)(R * g.lda + C) * 2u; voffB[i] = (unsigned)(Rb * g.ldb + C) * 2u; }
    const size_t kstep = (size_t)(BK * 2);
    const size_t hstepA = (size_t)HALF * g.lda * 2, hstepB = (size_t)HALF * g.ldb * 2;
    const size_t tstepA = 2 * hstepA, tstepB = 2 * hstepB;
#define PG8_UA(u) ((const char*)g.A + (size_t)(u).pm * tstepA + (g.asplit ? (size_t)((u).pn / g.asplit) * (size_t)g.astride * 2 : (size_t)0))
#define PG8_UB(u) ((const char*)g.Bt + (size_t)(u).pn * tstepB + (g.bsplit ? (size_t)((u).pm / g.bsplit) * (size_t)g.bstride * 2 : (size_t)0))
    const unsigned ldsw = (unsigned)wid * 1024u;
    const int aoff = lds_byte(wr * 64 + fr, fq * 8), boff = lds_byte(wc * 32 + fr, fq * 8);
#define PG8_SA(b, h) (((b) * 2 + (h)) * HTB)
#define PG8_SB(b, h) ((4 + (b) * 2 + (h)) * HTB)
#define PG8_STAGE(bufoff, gbase, voff) do { _Pragma("unroll") for (int _i = 0; _i < 2; ++_i) \
        __builtin_amdgcn_global_load_lds((const unsigned*)((const char*)(gbase) + (voff)[_i]), (PG8_LAS unsigned*)(lds + (bufoff) + ldsw + _i * 8192), 16, 0, 0); } while (0)
#define PG8_LDA(dst, b, h) do { _Pragma("unroll") for (int m = 0; m < 4; ++m) _Pragma("unroll") for (int k = 0; k < 2; ++k) dst[m][k] = *(const PG8_LAS bf16x8*)(lds + PG8_SA(b, h) + aoff + m * 2048 + k * 1024); } while (0)
#define PG8_LDB(dst, b, h) do { _Pragma("unroll") for (int n = 0; n < 2; ++n) _Pragma("unroll") for (int k = 0; k < 2; ++k) dst[n][k] = *(const PG8_LAS bf16x8*)(lds + PG8_SB(b, h) + boff + n * 2048 + k * 1024); } while (0)
#define PG8_MMA(ai, bj, At, Bt) do { __builtin_amdgcn_s_setprio(1); _Pragma("unroll") for (int m = 0; m < 4; ++m) _Pragma("unroll") for (int n = 0; n < 2; ++n) _Pragma("unroll") for (int k = 0; k < 2; ++k) \
        acc[ai][bj][m][n] = __builtin_amdgcn_mfma_f32_16x16x32_bf16(Bt[n][k], At[m][k], acc[ai][bj][m][n], 0, 0, 0); __builtin_amdgcn_s_setprio(0); } while (0)
#define PG8_WAIT_V(n) asm volatile("s_waitcnt vmcnt(" #n ")" ::: "memory")
#define PG8_WAIT_L(n) asm volatile("s_waitcnt lgkmcnt(" #n ")" ::: "memory")
#define PG8_BAR __builtin_amdgcn_s_barrier()
#define PG8_SCHED __builtin_amdgcn_sched_barrier(0)
    Unit cur, nxt; int ui = 0;
    if (!S.next(0, cur)) return;
    f32x4 acc[2][2][4][2];
#pragma unroll
    for (int a = 0; a < 2; ++a)
#pragma unroll
        for (int b = 0; b < 2; ++b)
#pragma unroll
            for (int m = 0; m < 4; ++m)
#pragma unroll
                for (int n = 0; n < 2; ++n) acc[a][b][m][n] = (f32x4){0.f, 0.f, 0.f, 0.f};
    bf16x8 At[4][2], B0[2][2], B1[2][2];
    const char* cA = PG8_UA(cur); const char* cB = PG8_UB(cur);
    S.a_ready(cur);
    if constexpr (SP2) {
        PG8_STAGE(PG8_SB(0, 0), cB, voffB); PG8_STAGE(PG8_SB(0, 1), cB + hstepB, voffB); PG8_STAGE(PG8_SA(0, 0), cA, voffA); PG8_STAGE(PG8_SA(0, 1), cA + hstepA, voffA);
        if (wr == 1) PG8_BAR;
        PG8_WAIT_V(2); PG8_BAR;
        PG8_STAGE(PG8_SB(1, 0), cB + kstep, voffB); PG8_STAGE(PG8_SA(1, 0), cA + kstep, voffA); PG8_STAGE(PG8_SB(1, 1), cB + hstepB + kstep, voffB);
        PG8_WAIT_V(6); PG8_BAR;
    } else {
        PG8_STAGE(PG8_SB(0, 0), cB, voffB); PG8_STAGE(PG8_SA(0, 0), cA, voffA); PG8_STAGE(PG8_SB(0, 1), cB + hstepB, voffB); PG8_STAGE(PG8_SA(0, 1), cA + hstepA, voffA);
        if (wr == 1) PG8_BAR;
        PG8_WAIT_V(4); PG8_BAR;
        PG8_STAGE(PG8_SB(1, 0), cB + kstep, voffB); PG8_STAGE(PG8_SA(1, 0), cA + kstep, voffA); PG8_STAGE(PG8_SB(1, 1), cB + hstepB + kstep, voffB);
        PG8_WAIT_V(6); PG8_BAR;
    }
    for (;;) {
        const bool has_next = S.next(ui + 1, nxt);
        const char* nA = has_next ? PG8_UA(nxt) : cA; const char* nB = has_next ? PG8_UB(nxt) : cB;
        for (int t = 0; t < nt; t += 2) {
            const bool last = (t == nt - 2);
            const char* a1 = cA + (size_t)(t + 1) * kstep;
            const char* a2 = last ? nA : cA + (size_t)(t + 2) * kstep; const char* b2 = last ? nB : cB + (size_t)(t + 2) * kstep;
            const char* a3 = a2 + kstep; const char* b3 = b2 + kstep;
            if (last && has_next) S.a_ready(nxt);
            if constexpr (SP2) {
            PG8_LDB(B0, 0, 0); PG8_LDB(B1, 0, 1); PG8_SCHED; PG8_LDA(At, 0, 0); PG8_STAGE(PG8_SA(1, 1), a1 + hstepA, voffA);
            PG8_WAIT_V(8); PG8_WAIT_L(0); PG8_BAR; PG8_MMA(0, 0, At, B0); PG8_MMA(0, 1, At, B1); PG8_BAR; PG8_SCHED;
            PG8_LDA(At, 0, 1); PG8_STAGE(PG8_SB(0, 0), b2, voffB); PG8_STAGE(PG8_SB(0, 1), b2 + hstepB, voffB); PG8_STAGE(PG8_SA(0, 0), a2, voffA);
            PG8_WAIT_V(8); PG8_WAIT_L(0); PG8_BAR; PG8_MMA(1, 0, At, B0); PG8_MMA(1, 1, At, B1); PG8_BAR; PG8_SCHED;
            PG8_LDB(B0, 1, 0); PG8_LDB(B1, 1, 1); PG8_SCHED; PG8_LDA(At, 1, 0); PG8_STAGE(PG8_SA(0, 1), a2 + hstepA, voffA);
            PG8_WAIT_V(8); PG8_WAIT_L(0); PG8_BAR; PG8_MMA(0, 0, At, B0); PG8_MMA(0, 1, At, B1); PG8_BAR; PG8_SCHED;
            PG8_LDA(At, 1, 1); PG8_STAGE(PG8_SB(1, 0), b3, voffB); PG8_STAGE(PG8_SB(1, 1), b3 + hstepB, voffB); PG8_STAGE(PG8_SA(1, 0), a3, voffA);
            PG8_WAIT_V(8); PG8_WAIT_L(0); PG8_BAR; PG8_MMA(1, 0, At, B0); PG8_MMA(1, 1, At, B1); PG8_BAR; PG8_SCHED;
            } else {
            PG8_LDB(B0, 0, 0); PG8_SCHED; PG8_LDA(At, 0, 0); PG8_STAGE(PG8_SA(1, 1), a1 + hstepA, voffA);
            PG8_WAIT_L(8); PG8_BAR; PG8_WAIT_L(0); PG8_MMA(0, 0, At, B0); PG8_BAR; PG8_SCHED;
            PG8_LDB(B1, 0, 1); PG8_STAGE(PG8_SB(0, 0), b2, voffB);
            PG8_BAR; PG8_WAIT_L(0); PG8_MMA(0, 1, At, B1); PG8_BAR;
            PG8_LDA(At, 0, 1); PG8_STAGE(PG8_SA(0, 0), a2, voffA);
            PG8_BAR; PG8_WAIT_L(0); PG8_MMA(1, 0, At, B0); PG8_BAR; PG8_SCHED;
            PG8_STAGE(PG8_SB(0, 1), b2 + hstepB, voffB);
            PG8_WAIT_V(6); PG8_BAR; PG8_MMA(1, 1, At, B1); PG8_BAR;
            PG8_LDB(B0, 1, 0); PG8_SCHED; PG8_LDA(At, 1, 0); PG8_STAGE(PG8_SA(0, 1), a2 + hstepA, voffA);
            PG8_WAIT_L(8); PG8_BAR; PG8_WAIT_L(0); PG8_MMA(0, 0, At, B0); PG8_BAR; PG8_SCHED;
            PG8_LDB(B1, 1, 1); PG8_STAGE(PG8_SB(1, 0), b3, voffB);
            PG8_BAR; PG8_WAIT_L(0); PG8_MMA(0, 1, At, B1); PG8_BAR;
            PG8_LDA(At, 1, 1); PG8_STAGE(PG8_SA(1, 0), a3, voffA);
            PG8_BAR; PG8_WAIT_L(0); PG8_MMA(1, 0, At, B0); PG8_BAR; PG8_SCHED;
            PG8_STAGE(PG8_SB(1, 1), b3 + hstepB, voffB);
            PG8_WAIT_V(6); PG8_BAR; PG8_MMA(1, 1, At, B1); PG8_BAR;
            }
        }
        if constexpr (ALIGN_EPI) { if (wr == 0) PG8_BAR; }
        if constexpr (!Epi::AFTER_DRAIN) { E(acc, cur, wr, wc, fr, fq); S.done(cur); }
        if (!has_next) break;
#pragma unroll
        for (int a = 0; a < 2; ++a)
#pragma unroll
            for (int b = 0; b < 2; ++b)
#pragma unroll
                for (int m = 0; m < 4; ++m)
#pragma unroll
                    for (int n = 0; n < 2; ++n) acc[a][b][m][n] = (f32x4){0.f, 0.f, 0.f, 0.f};
        cur = nxt; cA = nA; cB = nB; ++ui;
        if constexpr (ALIGN_EPI) { if (wr == 1) PG8_BAR; }
    }
    PG8_WAIT_V(0);
    if constexpr (!ALIGN_EPI) { if (wr == 0) PG8_BAR; }
    PG8_BAR;
    if constexpr (Epi::AFTER_DRAIN) { E.fused(acc, cur, wr, wc, fr, fq, lds, wid, lane); S.done(cur); }
#undef PG8_SA
#undef PG8_SB
#undef PG8_STAGE
#undef PG8_LDA
#undef PG8_LDB
#undef PG8_MMA
#undef PG8_WAIT_V
#undef PG8_WAIT_L
#undef PG8_BAR
#undef PG8_SCHED
#undef PG8_UA
#undef PG8_UB
}
}
namespace pg8 {
__device__ __forceinline__ float sigmoid_fast(float x) { return __builtin_amdgcn_rcpf(1.0f + __builtin_amdgcn_exp2f(-1.4426950408889634f * x)); }
__device__ __forceinline__ float bf_lo(unsigned w) { return __builtin_bit_cast(float, w << 16); }
__device__ __forceinline__ float bf_hi(unsigned w) { return __builtin_bit_cast(float, w & 0xffff0000u); }
struct EpiStore {
    static constexpr bool PERM = true, AFTER_DRAIN = false;
    bf16_t* O; int ldc; const float* bias;
    __device__ __forceinline__ void operator()(const f32x4 (&acc)[2][2][4][2], const Unit& u, int wr, int wc, int fr_, int fq_) const {
        int fr = fr_, fq = fq_; asm volatile("" : "+v"(fr), "+v"(fq));
        const int row0 = u.pm * BM + wr * 64 + fr, col0 = u.pn * BM + wc * 32 + 8 * fq;
        f32x4 bv[2][2];
#pragma unroll
        for (int bj = 0; bj < 2; ++bj)
#pragma unroll
            for (int n = 0; n < 2; ++n) bv[bj][n] = bias ? *(const f32x4*)(bias + col0 + bj * HALF + 4 * n) : (f32x4){0.f, 0.f, 0.f, 0.f};
#pragma unroll
        for (int ai = 0; ai < 2; ++ai)
#pragma unroll
            for (int m = 0; m < 4; ++m) { bf16_t* rowp = O + (size_t)(row0 + ai * HALF + m * 16) * ldc + col0;
#pragma unroll
                for (int bj = 0; bj < 2; ++bj) { const f32x4 v0 = acc[ai][bj][m][0] + bv[bj][0], v1 = acc[ai][bj][m][1] + bv[bj][1];
                    u32x4 w; w.x = cvt_pk_bf16(v0[0], v0[1]); w.y = cvt_pk_bf16(v0[2], v0[3]); w.z = cvt_pk_bf16(v1[0], v1[1]); w.w = cvt_pk_bf16(v1[2], v1[3]);
                    *(u32x4*)(rowp + bj * HALF) = w; } }
    }
};
struct EpiSwiGLU {
    static constexpr bool PERM = true, AFTER_DRAIN = false;
    bf16_t* O; int ldc;
    __device__ __forceinline__ void operator()(const f32x4 (&acc)[2][2][4][2], const Unit& u, int wr, int wc, int fr_, int fq_) const {
        int fr = fr_, fq = fq_; asm volatile("" : "+v"(fr), "+v"(fq));
        const int row0 = u.pm * BM + wr * 64 + fr, col0 = u.pn * HALF + wc * 32 + 8 * fq;
#pragma unroll
        for (int ai = 0; ai < 2; ++ai)
#pragma unroll
            for (int m = 0; m < 4; ++m) { bf16_t* rowp = O + (size_t)(row0 + ai * HALF + m * 16) * ldc + col0;
                float r[8];
#pragma unroll
                for (int n = 0; n < 2; ++n)
#pragma unroll
                    for (int e = 0; e < 4; ++e) { const float a = acc[ai][0][m][n][e], b = acc[ai][1][m][n][e]; r[4 * n + e] = a * sigmoid_fast(a) * b; }
                u32x4 w; w.x = cvt_pk_bf16(r[0], r[1]); w.y = cvt_pk_bf16(r[2], r[3]); w.z = cvt_pk_bf16(r[4], r[5]); w.w = cvt_pk_bf16(r[6], r[7]);
                *(u32x4*)rowp = w; }
    }
};
struct EpiGLU {
    static constexpr bool PERM = true, AFTER_DRAIN = false;
    bf16_t* O; int ldc; const bf16_t* Y; int ldy; const float* bias;
    __device__ __forceinline__ void operator()(const f32x4 (&acc)[2][2][4][2], const Unit& u, int wr, int wc, int fr_, int fq_) const {
        int fr = fr_, fq = fq_; asm volatile("" : "+v"(fr), "+v"(fq));
        const int row0 = u.pm * BM + wr * 64 + fr, col0 = u.pn * BM + wc * 32 + 8 * fq;
        f32x4 bv[2][2];
#pragma unroll
        for (int bj = 0; bj < 2; ++bj)
#pragma unroll
            for (int n = 0; n < 2; ++n) bv[bj][n] = *(const f32x4*)(bias + col0 + bj * HALF + 4 * n);
#pragma unroll
        for (int ai = 0; ai < 2; ++ai)
#pragma unroll
            for (int m = 0; m < 4; ++m) { const size_t r = (size_t)(row0 + ai * HALF + m * 16);
#pragma unroll
                for (int bj = 0; bj < 2; ++bj) { const u32x4 yw = *(const u32x4*)(Y + r * ldy + col0 + bj * HALF);
                    const f32x4 v0 = acc[ai][bj][m][0] + bv[bj][0], v1 = acc[ai][bj][m][1] + bv[bj][1];
                    u32x4 w; w.x = cvt_pk_bf16(bf_lo(yw.x) * sigmoid_fast(v0[0]), bf_hi(yw.x) * sigmoid_fast(v0[1])); w.y = cvt_pk_bf16(bf_lo(yw.y) * sigmoid_fast(v0[2]), bf_hi(yw.y) * sigmoid_fast(v0[3]));
                    w.z = cvt_pk_bf16(bf_lo(yw.z) * sigmoid_fast(v1[0]), bf_hi(yw.z) * sigmoid_fast(v1[1])); w.w = cvt_pk_bf16(bf_lo(yw.w) * sigmoid_fast(v1[2]), bf_hi(yw.w) * sigmoid_fast(v1[3]));
                    *(u32x4*)(O + r * ldc + col0 + bj * HALF) = w; } }
    }
};
struct EpiGate {
    static constexpr bool PERM = true, AFTER_DRAIN = false;
    bf16_t* O; int ldc; const bf16_t* L; int ldl;
    __device__ __forceinline__ void operator()(const f32x4 (&acc)[2][2][4][2], const Unit& u, int wr, int wc, int fr_, int fq_) const {
        int fr = fr_, fq = fq_; asm volatile("" : "+v"(fr), "+v"(fq));
        const int row0 = u.pm * BM + wr * 64 + fr, col0 = u.pn * BM + wc * 32 + 8 * fq;
#pragma unroll
        for (int ai = 0; ai < 2; ++ai)
#pragma unroll
            for (int m = 0; m < 4; ++m) { const size_t r = (size_t)(row0 + ai * HALF + m * 16);
#pragma unroll
                for (int bj = 0; bj < 2; ++bj) { const u32x4 lw = *(const u32x4*)(L + r * ldl + col0 + bj * HALF);
                    const f32x4 v0 = acc[ai][bj][m][0], v1 = acc[ai][bj][m][1];
                    u32x4 w; w.x = cvt_pk_bf16(v0[0] * sigmoid_fast(bf_lo(lw.x)), v0[1] * sigmoid_fast(bf_hi(lw.x))); w.y = cvt_pk_bf16(v0[2] * sigmoid_fast(bf_lo(lw.y)), v0[3] * sigmoid_fast(bf_hi(lw.y)));
                    w.z = cvt_pk_bf16(v1[0] * sigmoid_fast(bf_lo(lw.z)), v1[1] * sigmoid_fast(bf_hi(lw.z))); w.w = cvt_pk_bf16(v1[2] * sigmoid_fast(bf_lo(lw.w)), v1[3] * sigmoid_fast(bf_hi(lw.w)));
                    *(u32x4*)(O + r * ldc + col0 + bj * HALF) = w; } }
    }
};

struct EpiInProj {
    static constexpr bool PERM = true, AFTER_DRAIN = false;
    bf16_t* O; int ldc; const float* bias; bf16_t* U; int UT, NR, KE;
    __device__ __forceinline__ void operator()(const f32x4 (&acc)[2][2][4][2], const Unit& u, int wr, int wc, int fr_, int fq_) const {
        int fr = fr_, fq = fq_; asm volatile("" : "+v"(fr), "+v"(fq));
        const int row0 = u.pm * BM + wr * 64 + fr, col0 = u.pn * BM + wc * 32 + 8 * fq;
        f32x4 bv[2][2];
#pragma unroll
        for (int bj = 0; bj < 2; ++bj)
#pragma unroll
            for (int n = 0; n < 2; ++n) bv[bj][n] = *(const f32x4*)(bias + col0 + bj * HALF + 4 * n);
        const bool is_u = u.pn >= UT;
#pragma unroll
        for (int ai = 0; ai < 2; ++ai)
#pragma unroll
            for (int m = 0; m < 4; ++m) { const int row = row0 + ai * HALF + m * 16;
#pragma unroll
                for (int bj = 0; bj < 2; ++bj) { const f32x4 v0 = acc[ai][bj][m][0] + bv[bj][0], v1 = acc[ai][bj][m][1] + bv[bj][1];
                    u32x4 w; w.x = cvt_pk_bf16(v0[0], v0[1]); w.y = cvt_pk_bf16(v0[2], v0[3]); w.z = cvt_pk_bf16(v1[0], v1[1]); w.w = cvt_pk_bf16(v1[2], v1[3]);
                    if (!is_u) *(u32x4*)(O + (size_t)row * ldc + col0 + bj * HALF) = w;
                    else { const int j = col0 + bj * HALF - UT * BM, g = j >> 4, k0 = j & 15;
                        *(u32x4*)(U + ((size_t)g * NR + (row >> 4)) * KE + (row & 15) * 16 + k0) = w; } } }
    }
};
struct EpiSsmState {
    static constexpr bool PERM = false, AFTER_DRAIN = true;
    bf16_t* U; const float* dec; int KE;
    __device__ __forceinline__ void fused(f32x4 (&acc)[2][2][4][2], const Unit& u, int wr, int wc, int fr, int fq, PG8_LAS unsigned char* lds, int wid, int lane) const {
        typedef float f32x2v __attribute__((ext_vector_type(2)));
        PG8_LAS float* loc = (PG8_LAS float*)lds;
        PG8_LAS f32x2v* Eseg = (PG8_LAS f32x2v*)(lds + STAGE_BYTES + 1024);
#pragma unroll
        for (int ai = 0; ai < 2; ++ai)
#pragma unroll
            for (int m = 0; m < 4; ++m)
#pragma unroll
                for (int n = 0; n < 2; ++n) *(PG8_LAS f32x4*)(loc + (ai * HALF + wr * 64 + m * 16 + fr) * 128 + wc * 32 + n * 16 + fq * 4) = acc[ai][0][m][n];
        asm volatile("s_waitcnt lgkmcnt(0)" ::: "memory"); __builtin_amdgcn_s_barrier(); asm volatile("" ::: "memory");
        const int g = u.pm >> 2, p = lane;
        const float ar = dec[(g * 64 + p) * 2], ai_ = dec[(g * 64 + p) * 2 + 1];
        float xr = 0.f, xi = 0.f;
        for (int i = 0; i < 32; ++i) { const f32x2v l = *(const PG8_LAS f32x2v*)(loc + (wid * 32 + i) * 128 + 2 * p); const float nr = ar * xr - ai_ * xi + l.x, ni = ar * xi + ai_ * xr + l.y; xr = nr; xi = ni; }
        Eseg[wid * 64 + p] = (f32x2v){xr, xi};
        asm volatile("s_waitcnt lgkmcnt(0)" ::: "memory"); __builtin_amdgcn_s_barrier(); asm volatile("" ::: "memory");
        float br = ar, bi = ai_;
#pragma unroll
        for (int s = 0; s < 5; ++s) { const float t = br * br - bi * bi; bi = 2.f * br * bi; br = t; }
        xr = 0.f; xi = 0.f;
        for (int w2 = 0; w2 < wid; ++w2) { const f32x2v e = Eseg[w2 * 64 + p]; const float nr = br * xr - bi * xi + e.x, ni = br * xi + bi * xr + e.y; xr = nr; xi = ni; }
        bf16_t* up = U + ((size_t)u.pm * BM + wid * 32) * KE + 256 + 2 * p;
        for (int i = 0; i < 32; ++i) { *(unsigned*)(up + (size_t)i * KE) = cvt_pk_bf16(xr, xi);
            const f32x2v l = *(const PG8_LAS f32x2v*)(loc + (wid * 32 + i) * 128 + 2 * p); const float nr = ar * xr - ai_ * xi + l.x, ni = ar * xi + ai_ * xr + l.y; xr = nr; xi = ni; }
    }
};
__device__ __forceinline__ float gelu_tanh_f(float x) { const float t = 0.7978845608028654f * (x + 0.044715f * x * x * x); const float e = __builtin_amdgcn_exp2f(2.885390081777927f * t); return x - x * __builtin_amdgcn_rcpf(e + 1.0f); }
struct EpiSsmMain {
    static constexpr bool PERM = true, AFTER_DRAIN = false;
    bf16_t* Y; int ldy; const bf16_t* U; int KE, NR; const float* dsk;
    __device__ __forceinline__ void operator()(const f32x4 (&acc)[2][2][4][2], const Unit& u, int wr, int wc, int fr_, int fq_) const {
        int fr = fr_, fq = fq_; asm volatile("" : "+v"(fr), "+v"(fq));
        const int row0 = u.pm * BM + wr * 64 + fr, col0 = wc * 32 + 8 * fq, g = u.pm >> 2;
        f32x4 dv[2];
        dv[0] = *(const f32x4*)(dsk + g * 16 + (col0 & 15)); dv[1] = *(const f32x4*)(dsk + g * 16 + (col0 & 15) + 4);
        const bf16_t* Ub = U + (size_t)row0 * KE + col0;
        bf16_t* Yb = Y + ((size_t)(row0 - g * NR) * 16 + (col0 >> 4)) * ldy + g * 16 + (col0 & 15);
#pragma unroll
        for (int ai = 0; ai < 2; ++ai)
#pragma unroll
            for (int m = 0; m < 4; ++m) {
#pragma unroll
                for (int bj = 0; bj < 2; ++bj) {
                    const u32x4 uw = *(const u32x4*)(Ub + (size_t)(ai * HALF + m * 16) * KE + bj * HALF);
                    const f32x4 a0 = acc[ai][bj][m][0], a1 = acc[ai][bj][m][1];
                    u32x4 w;
                    w.x = cvt_pk_bf16(gelu_tanh_f(a0[0] + dv[0][0] * bf_lo(uw.x)), gelu_tanh_f(a0[1] + dv[0][1] * bf_hi(uw.x)));
                    w.y = cvt_pk_bf16(gelu_tanh_f(a0[2] + dv[0][2] * bf_lo(uw.y)), gelu_tanh_f(a0[3] + dv[0][3] * bf_hi(uw.y)));
                    w.z = cvt_pk_bf16(gelu_tanh_f(a1[0] + dv[1][0] * bf_lo(uw.z)), gelu_tanh_f(a1[1] + dv[1][1] * bf_hi(uw.z)));
                    w.w = cvt_pk_bf16(gelu_tanh_f(a1[2] + dv[1][2] * bf_lo(uw.w)), gelu_tanh_f(a1[3] + dv[1][3] * bf_hi(uw.w)));
                    *(u32x4*)(Yb + ((size_t)(ai * HALF + m * 16) * 16 + 8 * bj) * ldy) = w;
                    asm volatile("" ::: "memory"); } }
    }
};

struct BranchOrder {
    StaticOrder so;
    __host__ __device__ void init(int M, int G_, int c_) { so.init(M, 1024, G_, c_); }
    __host__ __device__ bool next(int i, Unit& u) const { const int r = i / 3, br = i - 3 * r; if (!so.next(r, u)) return false; u.pn += 4 * br; return true; }
    __device__ __forceinline__ void a_ready(const Unit&) const {}
    __device__ __forceinline__ void done(const Unit&) const {}
};
struct EpiGateAcc {
    static constexpr bool PERM = true, AFTER_DRAIN = false;
    float* Mb; bf16_t* O; int ldc; const bf16_t* L; int ldl;
    __device__ __forceinline__ void operator()(const f32x4 (&acc)[2][2][4][2], const Unit& u, int wr, int wc, int fr_, int fq_) const {
        int fr = fr_, fq = fq_; asm volatile("" : "+v"(fr), "+v"(fq));
        const int br = u.pn >> 2, row0 = u.pm * BM + wr * 64 + fr, col0 = (u.pn & 3) * BM + wc * 32 + 8 * fq;
        const bf16_t* Lb = L + (size_t)row0 * ldl + br * 1024 + col0; float* Mp = Mb + (size_t)row0 * ldc + col0; bf16_t* Ob = O + (size_t)row0 * ldc + col0;
#pragma unroll
        for (int ai = 0; ai < 2; ++ai)
#pragma unroll
            for (int m = 0; m < 4; ++m) { const size_t ro = (size_t)(ai * HALF + m * 16);
#pragma unroll
                for (int bj = 0; bj < 2; ++bj) { const u32x4 lw = *(const u32x4*)(Lb + ro * ldl + bj * HALF);
                    f32x4 v0 = acc[ai][bj][m][0], v1 = acc[ai][bj][m][1];
                    v0[0] *= sigmoid_fast(bf_lo(lw.x)); v0[1] *= sigmoid_fast(bf_hi(lw.x)); v0[2] *= sigmoid_fast(bf_lo(lw.y)); v0[3] *= sigmoid_fast(bf_hi(lw.y));
                    v1[0] *= sigmoid_fast(bf_lo(lw.z)); v1[1] *= sigmoid_fast(bf_hi(lw.z)); v1[2] *= sigmoid_fast(bf_lo(lw.w)); v1[3] *= sigmoid_fast(bf_hi(lw.w));
                    float* mp = Mp + ro * ldc + bj * HALF;
                    if (br > 0) { v0 += *(const f32x4*)mp; v1 += *(const f32x4*)(mp + 4); }
                    if (br < 2) { *(f32x4*)mp = v0; *(f32x4*)(mp + 4) = v1; }
                    else { u32x4 w; w.x = cvt_pk_bf16(v0[0], v0[1]); w.y = cvt_pk_bf16(v0[2], v0[3]); w.z = cvt_pk_bf16(v1[0], v1[1]); w.w = cvt_pk_bf16(v1[2], v1[3]);
                        *(u32x4*)(Ob + ro * ldc + bj * HALF) = w; } }
                asm volatile("" ::: "memory"); }
    }
};
}
#define GAS __attribute__((address_space(1)))
#define LAS __attribute__((address_space(3)))
typedef unsigned short bf16;
typedef unsigned v4u __attribute__((ext_vector_type(4)));
typedef float f32x4 __attribute__((ext_vector_type(4)));
typedef short bf16x8 __attribute__((ext_vector_type(8)));
typedef GAS unsigned gu32;
typedef GAS unsigned long long gu64;
#define RLX_AGENT __ATOMIC_RELAXED, __HIP_MEMORY_SCOPE_AGENT
#define LDS_WAIT() asm volatile("s_waitcnt lgkmcnt(0)" ::: "memory")
#define VM_WAIT() asm volatile("s_waitcnt vmcnt(0)" ::: "memory")
__device__ __forceinline__ unsigned long long rt() { return __builtin_amdgcn_s_memrealtime(); }
__device__ __forceinline__ unsigned f2bf(float f) { unsigned u = __builtin_bit_cast(unsigned, f); return (u + 0x7fffu + ((u >> 16) & 1u)) >> 16; }
__device__ __forceinline__ unsigned pk2(float lo, float hi) { return f2bf(lo) | (f2bf(hi) << 16); }

#define XB_TMO      128
#define XB_XCNT(j)  (256  + 64 * (j))
#define XB_XSUB(j)  (1280 + 64 * (j))
#define XB_XGEN(j)  (2304 + 64 * (j))
#define XB_TOP      3328
#define XB_TOPGEN   3392
#define XCD_BAR_WORDS 3456
#define XB_SPIN_CAP (1u << 22)

__device__ __forceinline__ unsigned xb_ld(unsigned* p)              { return __hip_atomic_load(p, __ATOMIC_RELAXED, __HIP_MEMORY_SCOPE_AGENT); }
__device__ __forceinline__ unsigned xb_add(unsigned* p, unsigned v) { return __hip_atomic_fetch_add(p, v, __ATOMIC_RELAXED, __HIP_MEMORY_SCOPE_AGENT); }
__device__ __forceinline__ unsigned xb_xcc_id() { return (unsigned)__builtin_amdgcn_s_getreg((3 << 11) | 20) & 0xFu; }
#define XB_SPIN(cond, bar) do { unsigned _sp = 0; while (cond) { __builtin_amdgcn_s_sleep(1); \
    if ((++_sp & 255u) == 0u) { if (xb_ld(&(bar)[XB_TMO])) break; if (_sp > XB_SPIN_CAP) { atomicAdd(&(bar)[XB_TMO], 1u); break; } } } } while (0)

struct XcdBarrier {
    unsigned* bar; unsigned x;
    volatile LAS unsigned* st;
};

__device__ __forceinline__ XcdBarrier xcd_barrier_post(unsigned* bar, volatile LAS unsigned* st) {
    XcdBarrier b; b.bar = bar; b.x = xb_xcc_id(); b.st = st;
    if (threadIdx.x == 0) (void)xb_add(&bar[XB_XCNT(b.x)], 1u);
    return b;
}
__device__ __forceinline__ void xcd_barrier_complete(unsigned* bar, unsigned x, unsigned& nloc, unsigned& nx) {
    const unsigned G = gridDim.x * gridDim.y * gridDim.z;
    unsigned sum, cnt, mine, sp = 0u;
    for (;;) {
        sum = 0u; cnt = 0u; mine = 0u;
#pragma unroll
        for (unsigned j = 0; j < 16; ++j) { const unsigned c = xb_ld(&bar[XB_XCNT(j)]); sum += c; cnt += (c > 0u) ? 1u : 0u; mine = (j == x) ? c : mine; }
        if (sum == G) break;
        __builtin_amdgcn_s_sleep(1);
        if ((++sp & 255u) == 0u) { if (xb_ld(&bar[XB_TMO])) break; if (sp > XB_SPIN_CAP) { atomicAdd(&bar[XB_TMO], 1u); break; } }
    }
    nloc = mine > 0u ? mine : 1u; nx = cnt > 0u ? cnt : 1u;
}

__device__ __forceinline__ void xcd_barrier(const XcdBarrier& b, int tid_) {
    asm volatile("s_waitcnt vmcnt(0)" ::: "memory");
    __syncthreads();
    if (tid_ == 0) {
        unsigned* bar = b.bar;
        __builtin_amdgcn_s_waitcnt(0);
        unsigned nloc = b.st[0], nx = b.st[1];
        if (nloc == 0u) { xcd_barrier_complete(bar, b.x, nloc, nx); b.st[0] = nloc; b.st[1] = nx; }
        const unsigned old = xb_add(&bar[XB_XSUB(b.x)], 1u);
        const unsigned gen = old / nloc;
        if (old + 1u == (gen + 1u) * nloc) {
            __builtin_amdgcn_fence(__ATOMIC_RELEASE, "agent");
            asm volatile("s_waitcnt vmcnt(0)" ::: "memory");
            const unsigned og = xb_add(&bar[XB_TOP], 1u);
            const unsigned tg = og / nx;
            if (og + 1u == (tg + 1u) * nx) xb_add(&bar[XB_TOPGEN], 1u);
            else XB_SPIN(xb_ld(&bar[XB_TOPGEN]) == tg, bar);
            __builtin_amdgcn_fence(__ATOMIC_ACQUIRE, "agent");
            xb_add(&bar[XB_XGEN(b.x)], 1u);
            asm volatile("s_waitcnt vmcnt(0)" ::: "memory");
        } else {
            XB_SPIN(xb_ld(&bar[XB_XGEN(b.x)]) == gen, bar);
            __builtin_amdgcn_fence(__ATOMIC_ACQUIRE, "agent");
            asm volatile("s_waitcnt vmcnt(0)" ::: "memory");
        }
    }
    __syncthreads();
}

constexpr int NWAVES = 8;
constexpr int DM = 1024, NBATCH = 16, SEQ = 4096, DEPTH = 4, DFF = 2816, MALL = NBATCH * SEQ;
constexpr int NIN = 8864, NINP = 8960;
constexpr int C_QA = 0, C_KVA = 384, C_KR = 640, C_DIL = 672, C_GATE = 5280, C_PAD = 8352, C_U = 8448;
constexpr int SRC_U = 5280, SRC_GATE = 5792;
constexpr int QR = 384, KVR = 256;
constexpr int CHB = 4, CHROWS = CHB * SEQ, NCHUNK = NBATCH / CHB;
constexpr float LN_EPS = 1e-5f, RMS_EPS = 1e-6f;
constexpr float DN_ALPHA = 1.681792830507429f;
constexpr float LOG2E = 1.4426950408889634f;

constexpr size_t MiB = 1u << 20;
constexpr size_t WS_CTL = 0, CTL_ZERO_BYTES = 1 * MiB;
constexpr size_t WS_ADA = 1 * MiB;
constexpr size_t WS_SMALL = 4 * MiB;
constexpr size_t SM_BIAS = 0, SM_PW = 64 * 1024, SM_BRE = 384 * 1024, SM_BIM = 512 * 1024, SM_CRE = 640 * 1024, SM_CIM = 768 * 1024, SM_DEC = 896 * 1024;
constexpr int SSM_T = 16, SSM_NR = 1024  , SSM_KE = 384  ;
constexpr size_t WS_ROPE = 6 * MiB;
constexpr size_t WS_W = 14 * MiB;
constexpr size_t W_13 = 0, W_13_SZ = (size_t)2 * DFF * DM * 2;
constexpr size_t W_2 = W_13 + 2 * W_13_SZ, W_2_SZ = (size_t)DM * DFF * 2;
constexpr size_t W_IN = W_2 + 2 * W_2_SZ, W_IN_SZ = (size_t)NINP * DM * 2;
constexpr size_t W_QB = W_IN + W_IN_SZ, W_QB_SZ = (size_t)768 * QR * 2;
constexpr size_t W_KVB = W_QB + W_QB_SZ, W_KVB_SZ = (size_t)1024 * KVR * 2;
constexpr size_t W_GLU = W_KVB + W_KVB_SZ, W_GLU_SZ = (size_t)512 * 512 * 2;
constexpr size_t W_BR = W_GLU + W_GLU_SZ, W_BR_SZ = (size_t)3072 * 512 * 2;
constexpr size_t W_OUT = W_BR + W_BR_SZ, W_OUT_SZ = (size_t)1024 * 3072 * 2;
constexpr size_t W_SM = W_OUT + W_OUT_SZ, W_SM_SZ = (size_t)32 * 256 * SSM_KE * 2;
constexpr size_t W_SS = W_SM + W_SM_SZ, W_SS_SZ = (size_t)32 * 256 * 256 * 2;
constexpr size_t W_END = W_SS + W_SS_SZ;
static_assert(W_END <= 80 * MiB, "weights region");
constexpr size_t WS_HM = 94 * MiB;
constexpr size_t WS_H16 = 222 * MiB;
constexpr size_t WS_BIG = 350 * MiB;
constexpr size_t WS_G = WS_BIG;
constexpr size_t WS_F_FFN = WS_BIG + 352 * MiB;
constexpr size_t WS_F_MIX = WS_BIG;
constexpr size_t WS_PROJ = WS_BIG;
constexpr size_t WS_QRAW = WS_BIG + 280 * MiB;
constexpr size_t WS_KVRAW = WS_QRAW + 24 * MiB;
constexpr size_t WS_QF = WS_KVRAW + 32 * MiB;
constexpr size_t WS_KF = WS_QF + 24 * MiB;
constexpr size_t WS_VF = WS_KF + 24 * MiB;
constexpr size_t WS_YS = WS_VF + 16 * MiB;
constexpr size_t WS_Y3 = WS_YS + 16 * MiB;
constexpr size_t WS_OG = WS_Y3 + 48 * MiB;
constexpr size_t WS_LSE = WS_OG + 48 * MiB;
constexpr size_t WS_T = WS_LSE + 1 * MiB;
constexpr size_t WS_UG = WS_T + 96 * MiB;
constexpr size_t WS_END = WS_UG + 24 * MiB;
static_assert(WS_END <= 1024 * MiB && WS_F_FFN + (size_t)MALL * DM * 2 <= 1024 * MiB && WS_H16 + (size_t)MALL * DM * 2 <= WS_BIG, "d_ws map");
constexpr int CW_BAR = 4096;

constexpr int RING_OFF = 0, RING_BYTES = 131072;
constexpr int LDSCTL_OFF = RING_BYTES, MISC_OFF = LDSCTL_OFF + 320;
constexpr int LDS_BYTES = 147456;

typedef unsigned v2u __attribute__((ext_vector_type(2)));
struct Frame {
    LAS unsigned char* lds;
    int tid, lane, wave, G, bid;
};
struct Args { const void* in[28]; float* out; unsigned char* ws; int ph_lo, ph_hi; };

__device__ __forceinline__ float lane_xor(float v, int o, int lane) { return __builtin_bit_cast(float, __builtin_amdgcn_ds_bpermute((lane ^ o) << 2, __builtin_bit_cast(int, v))); }
__device__ __forceinline__ float lane_get(float v, int src) { return __builtin_bit_cast(float, __builtin_amdgcn_ds_bpermute(src << 2, __builtin_bit_cast(int, v))); }
__device__ __forceinline__ float wave_sum(float v, int lane) {
#pragma unroll
    for (int o = 1; o < 64; o <<= 1) v += lane_xor(v, o, lane);
    return v;
}
__device__ __forceinline__ float bf2f(unsigned short h) { return __builtin_bit_cast(float, (unsigned)h << 16); }
__device__ __forceinline__ float bflo(unsigned w) { return __builtin_bit_cast(float, w << 16); }
__device__ __forceinline__ float bfhi(unsigned w) { return __builtin_bit_cast(float, w & 0xffff0000u); }

__device__ __forceinline__ void phase_ada(Frame& F, const float* cvec, const float* w_ada, const float* b_ada, float* ada) {
    LAS float* cond = (LAS float*)(F.lds);
    LAS float* red = (LAS float*)(F.lds + 65536);
    for (int u = F.bid; u < DEPTH * 64; u += F.G) {
        const int l = u >> 6, n0 = (u & 63) * 144;
        for (int i = F.tid; i < NBATCH * DM; i += NWAVES * 64) { const float c = cvec[i]; cond[(i & 1023) * 16 + (i >> 10)] = c / (1.0f + __expf(-c)); }
        __syncthreads();
        const int ks = F.tid / 36, q = F.tid - ks * 36;
        float acc[16][4];
#pragma unroll
        for (int b = 0; b < 16; ++b) { acc[b][0] = 0.f; acc[b][1] = 0.f; acc[b][2] = 0.f; acc[b][3] = 0.f; }
        if (ks < 14) {
            const int k0 = (ks * 1024) / 14, k1 = ((ks + 1) * 1024) / 14;
            const float* wp = w_ada + ((size_t)l * DM) * 9216 + n0 + 4 * q;
#pragma unroll 8
            for (int k = k0; k < k1; ++k) { const f32x4 w = *(const f32x4*)(wp + (size_t)k * 9216);
#pragma unroll
                for (int b4 = 0; b4 < 4; ++b4) { const f32x4 c = *(const LAS f32x4*)(cond + k * 16 + 4 * b4);
                    acc[4 * b4 + 0][0] += c.x * w.x; acc[4 * b4 + 0][1] += c.x * w.y; acc[4 * b4 + 0][2] += c.x * w.z; acc[4 * b4 + 0][3] += c.x * w.w;
                    acc[4 * b4 + 1][0] += c.y * w.x; acc[4 * b4 + 1][1] += c.y * w.y; acc[4 * b4 + 1][2] += c.y * w.z; acc[4 * b4 + 1][3] += c.y * w.w;
                    acc[4 * b4 + 2][0] += c.z * w.x; acc[4 * b4 + 2][1] += c.z * w.y; acc[4 * b4 + 2][2] += c.z * w.z; acc[4 * b4 + 2][3] += c.z * w.w;
                    acc[4 * b4 + 3][0] += c.w * w.x; acc[4 * b4 + 3][1] += c.w * w.y; acc[4 * b4 + 3][2] += c.w * w.z; acc[4 * b4 + 3][3] += c.w * w.w; } }
        }
        float ps[5];
#pragma unroll
        for (int r = 0; r < 2; ++r) {
            if (ks < 14 && ks / 7 == r) { const int kr = ks - 7 * r;
#pragma unroll
                for (int b = 0; b < 16; ++b) *(LAS f32x4*)(red + (kr * 16 + b) * 144 + 4 * q) = (f32x4){acc[b][0], acc[b][1], acc[b][2], acc[b][3]}; }
            __syncthreads();
#pragma unroll
            for (int i = 0; i < 5; ++i) { const int idx = F.tid + 512 * i;
                if (idx < 2304) { float sm = (r == 0) ? 0.f : ps[i];
#pragma unroll
                    for (int kr = 0; kr < 7; ++kr) sm += red[kr * 2304 + idx];
                    ps[i] = sm; } }
            __syncthreads();
        }
#pragma unroll
        for (int i = 0; i < 5; ++i) { const int idx = F.tid + 512 * i;
            if (idx < 2304) { const int b = idx / 144, n = idx - b * 144; ada[((size_t)l * 16 + b) * 9216 + n0 + n] = ps[i] + b_ada[(size_t)l * 9216 + n0 + n]; } }
    }
}

__device__ __forceinline__ void conv_item(const float* W, int N, bf16* dst, int pitch, int koff, int mode, int hi, const float* kscale, LAS float* scr, int item, int lane, int ncopy) {
    const int nblk = N / 32, kb = item / nblk, nb = item % nblk, k0 = 64 * kb, n0 = 32 * nb;
#pragma unroll 8
    for (int i = 0; i < 32; ++i) { const int kk = 2 * i + (lane >> 5); float v = W[(size_t)(k0 + kk) * N + n0 + (lane & 31)]; if (kscale) v *= kscale[k0 + kk]; scr[kk * 33 + (lane & 31)] = v; }
    LDS_WAIT(); asm volatile("" ::: "memory");
    const int c = lane & 7;
    const int r0 = (mode == 0) ? n0 : (mode == 1) ? ((n0 >> 7) * 256 + (n0 & 127) + (hi ? 128 : 0)) : (n0 < SRC_U ? n0 : (n0 < SRC_GATE ? n0 - SRC_U + C_U : n0 - (SRC_GATE - C_GATE)));
#pragma unroll
    for (int j = 0; j < 4; ++j) { const int n = (lane >> 3) + 8 * j; const LAS float* s = scr + (8 * c) * 33 + n;
        v4u o; o.x = pk2(s[0 * 33], s[1 * 33]); o.y = pk2(s[2 * 33], s[3 * 33]); o.z = pk2(s[4 * 33], s[5 * 33]); o.w = pk2(s[6 * 33], s[7 * 33]);
        for (int cp = 0; cp < ncopy; ++cp) *(GAS v4u*)(dst + (size_t)(r0 + n) * pitch + koff + cp * 1024 + k0 + 8 * c) = o; }
    LDS_WAIT(); asm volatile("" ::: "memory");
}
__device__ __forceinline__ void conv_job(Frame& F, const float* W, int K, int N, bf16* dst, int pitch, int mode, int hi, const float* kscale, int ncopy) {
    LAS float* scr = (LAS float*)(F.lds + RING_OFF + F.wave * 16384);
    const int gw = F.bid * NWAVES + F.wave, NGW = F.G * NWAVES, nitems = (K / 64) * (N / 32);
    for (int it = gw; it < nitems; it += NGW) conv_item(W, N, dst, pitch, 0, mode, hi, kscale, scr, it, F.lane, ncopy);
}
__device__ __forceinline__ void phase_wconv(Frame& F, const Args& A, int l) {
    unsigned char* ws = A.ws; bf16* wb = (bf16*)(ws + WS_W);
    {
        LAS float* scr = (LAS float*)(F.lds + RING_OFF + F.wave * 16384);
        const int gw = F.bid * NWAVES + F.wave, NGW = F.G * NWAVES;
#pragma nounroll
        for (int it = gw; it < 14560; it += NGW) {
            int j, loc;
            if (it < 8448) { j = it / 1408; loc = it - j * 1408; }
            else if (it < 12880) { j = 6; loc = it - 8448; }
            else if (it < 13024) { j = 7; loc = it - 12880; }
            else if (it < 13152) { j = 8; loc = it - 13024; }
            else if (it < 13280) { j = 9; loc = it - 13152; }
            else if (it < 14048) { const int q = (it - 13280) >> 8; j = 10 + q; loc = (it - 13280) & 255; }
            else { j = 13; loc = it - 14048; }
            const float* src; int N, pitch, mode = 0, hi = 0; size_t dsto; const float* ksc = nullptr;
            if (j < 6) { const int s = j / 3, t = j - 3 * s; const size_t o13 = ((size_t)l * 2 + s) * DM * DFF;
                if (t == 0) { src = (const float*)A.in[7] + o13; N = DFF; pitch = DM; mode = 1; hi = 0; dsto = W_13 + s * W_13_SZ; }
                else if (t == 1) { src = (const float*)A.in[8] + o13; N = DFF; pitch = DM; mode = 1; hi = 1; dsto = W_13 + s * W_13_SZ; }
                else { src = (const float*)A.in[9] + o13; N = DM; pitch = DFF; dsto = W_2 + s * W_2_SZ; } }
            else if (j == 6) { src = (const float*)A.in[10] + (size_t)l * DM * NIN; N = NIN; pitch = DM; dsto = W_IN; mode = 2; }
            else if (j == 7) { src = (const float*)A.in[14] + (size_t)l * QR * 768; N = 768; pitch = QR; dsto = W_QB; ksc = (const float*)A.in[12] + l * QR; }
            else if (j == 8) { src = (const float*)A.in[15] + (size_t)l * KVR * 1024; N = 1024; pitch = KVR; dsto = W_KVB; ksc = (const float*)A.in[13] + l * KVR; }
            else if (j == 9) { src = (const float*)A.in[24] + (size_t)l * 512 * 512; N = 512; pitch = 512; dsto = W_GLU; }
            else if (j < 13) { const int i = j - 10; src = (const float*)A.in[26] + ((size_t)l * 3 + i) * 512 * 1024; N = 1024; pitch = 512; dsto = W_BR + (size_t)i * 1024 * 512 * 2; }
            else { src = (const float*)A.in[27] + (size_t)l * DM * DM; N = DM; pitch = DM; dsto = W_OUT; }
            conv_item(src, N, (bf16*)((unsigned char*)wb + dsto), pitch, 0, mode, hi, ksc, scr, loc, F.lane, 1);
        }
    }
    const int gt = F.bid * (NWAVES * 64) + F.tid, NT = F.G * NWAVES * 64;
    { GAS v4u* z = (GAS v4u*)((unsigned char*)wb + W_IN + (size_t)C_PAD * DM * 2); const int nz = (C_U - C_PAD) * DM * 2 / 16;
      unsigned zz = 0u; asm volatile("" : "+v"(zz));
      for (int i = gt; i < nz; i += NT) z[i] = (v4u){zz, zz, zz, zz}; }
    { float* bp = (float*)(ws + WS_SMALL + SM_BIAS); const float* bin = (const float*)A.in[11] + (size_t)l * NIN;
      for (int i = gt; i < NINP; i += NT) bp[i] = (i < C_GATE) ? bin[i] : (i < C_PAD) ? bin[i + (SRC_GATE - C_GATE)] : (i < C_U) ? 0.f : bin[SRC_U + i - C_U]; }
    { const float* lre = (const float*)A.in[16] + l * 2048; const float* lim = (const float*)A.in[17] + l * 2048; const float* ldt = (const float*)A.in[18] + l * 32;
      const float* bre = (const float*)A.in[19] + (size_t)l * 32768; const float* bim = (const float*)A.in[20] + (size_t)l * 32768;
      const float* cre = (const float*)A.in[21] + (size_t)l * 32768; const float* cim = (const float*)A.in[22] + (size_t)l * 32768;
      float* tpw = (float*)(ws + WS_SMALL + SM_PW); float* tbr = (float*)(ws + WS_SMALL + SM_BRE); float* tbi = (float*)(ws + WS_SMALL + SM_BIM);
      float* tcr = (float*)(ws + WS_SMALL + SM_CRE); float* tci = (float*)(ws + WS_SMALL + SM_CIM); float* tdec = (float*)(ws + WS_SMALL + SM_DEC);
      for (int it = gt; it < 2048 * 17; it += NT) { const int i = it / 17, d = it - 17 * i, g = i >> 6;
          const float dt = expf(ldt[g]), zr = lre[i] * dt, zi = lim[i] * dt;
          const float mg = expf(zr * (float)d), an = zi * (float)d; tpw[(size_t)it * 2] = mg * cosf(an); tpw[(size_t)it * 2 + 1] = mg * sinf(an);
          if (d == 16) { tdec[2 * i] = expf(zr * 16.f) * cosf(zi * 16.f); tdec[2 * i + 1] = expf(zr * 16.f) * sinf(zi * 16.f); } }
      for (int it = gt; it < 32768; it += NT) { const int i = it >> 4, h = it & 15, g = i >> 6, p = i & 63;
          const float dt = expf(ldt[g]), lr = lre[i], li = lim[i], zr = lr * dt, zi = li * dt;
          const float e = expf(zr), cz = cosf(zi), sz = sinf(zi), sh = sinf(0.5f * zi);
          const float nr = expm1f(zr) * cz - 2.0f * sh * sh, ni = e * sz;
          const float den = 1.0f / (lr * lr + li * li), qr = (nr * lr + ni * li) * den, qi = (ni * lr - nr * li) * den;
          const float br = bre[it], bi = bim[it];
          tbr[it] = qr * br - qi * bi; tbi[it] = qr * bi + qi * br;
          tcr[it] = cre[((size_t)g * 16 + h) * 64 + p]; tci[it] = cim[((size_t)g * 16 + h) * 64 + p];
      } }
}
__device__ __forceinline__ void phase_ssm_weights(Frame& F, unsigned char* ws) {
    const float* tpw = (const float*)(ws + WS_SMALL + SM_PW); const float* tbr = (const float*)(ws + WS_SMALL + SM_BRE); const float* tbi = (const float*)(ws + WS_SMALL + SM_BIM);
    const float* tcr = (const float*)(ws + WS_SMALL + SM_CRE); const float* tci = (const float*)(ws + WS_SMALL + SM_CIM);
    bf16* Wm = (bf16*)(ws + WS_W + W_SM); bf16* Wsb = (bf16*)(ws + WS_W + W_SS);
    const int gt = F.bid * (NWAVES * 64) + F.tid, NT = F.G * NWAVES * 64;
    for (int idx = gt; idx < 32 * 16 * 16 * 16; idx += NT) { const int g = idx >> 12, d = (idx >> 8) & 15, k = (idx >> 4) & 15, h = idx & 15;
        float acc = 0.f;
        for (int p = 0; p < 64; ++p) { const size_t i = (size_t)g * 64 + p; const float pr = tpw[(i * 17 + d) * 2], pi = tpw[(i * 17 + d) * 2 + 1], br = tbr[i * 16 + h], bi = tbi[i * 16 + h], cr = tcr[i * 16 + k], ci = tci[i * 16 + k];
            const float wr = pr * br - pi * bi, wi = pr * bi + pi * br; acc += cr * wr - ci * wi; }
        const bf16 v = (bf16)f2bf(acc);
        for (int t = d; t < 16; ++t) Wm[((size_t)g * 256 + t * 16 + k) * SSM_KE + (t - d) * 16 + h] = v;
        if (d >= 1) for (int t = 0; t + d < 16; ++t) Wm[((size_t)g * 256 + t * 16 + k) * SSM_KE + (t + d) * 16 + h] = (bf16)0; }
    for (int idx = gt; idx < 32 * 16 * 16 * 64; idx += NT) { const int g = idx >> 14, t = (idx >> 10) & 15, k = (idx >> 6) & 15, p = idx & 63; const size_t i = (size_t)g * 64 + p;
        const float pr = tpw[(i * 17 + t + 1) * 2], pi = tpw[(i * 17 + t + 1) * 2 + 1], cr = tcr[i * 16 + k], ci = tci[i * 16 + k];
        *(GAS unsigned*)(Wm + ((size_t)g * 256 + t * 16 + k) * SSM_KE + 256 + 2 * p) = pk2(cr * pr - ci * pi, -(cr * pi + ci * pr)); }
    for (int idx = gt; idx < 32 * 64 * 16 * 16; idx += NT) { const int g = idx >> 14, p = (idx >> 8) & 63, s = (idx >> 4) & 15, h = idx & 15; const size_t i = (size_t)g * 64 + p;
        const float pr = tpw[(i * 17 + 15 - s) * 2], pi = tpw[(i * 17 + 15 - s) * 2 + 1], br = tbr[i * 16 + h], bi = tbi[i * 16 + h];
        Wsb[((size_t)g * 256 + 2 * p) * 256 + s * 16 + h] = (bf16)f2bf(pr * br - pi * bi); Wsb[((size_t)g * 256 + 2 * p + 1) * 256 + s * 16 + h] = (bf16)f2bf(pr * bi + pi * br); }
    { unsigned zz = 0u; asm volatile("" : "+v"(zz));
      for (int idx = gt; idx < 32 * 128 * 256 / 8; idx += NT) { const int g = idx >> 12, r = idx & 4095;
          *(GAS v4u*)(Wsb + ((size_t)g * 256 + 128) * 256 + (size_t)r * 8) = (v4u){zz, zz, zz, zz}; } }
}

typedef _Float16 h16x4 __attribute__((ext_vector_type(4)));
__device__ __forceinline__ void phase_lnmod(Frame& F, bool do_ln, const float* hin32, const _Float16* hin16, const bf16* Fs, float* hout32, _Float16* hout16, bf16* hm, int row0, int nrows,
                                            const float* ada_gate  , float rw, const float* lng, const float* lnb, const float* ada_next  ) {
    const int gw = F.bid * NWAVES + F.wave, NGW = F.G * NWAVES, rpw = nrows / NGW;
    const int r_begin = row0 + gw * rpw, b = r_begin / SEQ, lane = F.lane;
    f32x4 ga[4], lg[4], lb[4], sc[4], sh[4];
#pragma unroll
    for (int j = 0; j < 4; ++j) { const int c = 4 * lane + 256 * j;
        if (do_ln) { ga[j] = *(const f32x4*)(ada_gate + (size_t)b * 9216 + c) * rw; lg[j] = *(const f32x4*)(lng + c); lb[j] = *(const f32x4*)(lnb + c); }
        else { ga[j] = (f32x4){0.f, 0.f, 0.f, 0.f}; lg[j] = ga[j]; lb[j] = ga[j]; }
        if (hm) { sh[j] = *(const f32x4*)(ada_next + (size_t)b * 9216 + c); sc[j] = *(const f32x4*)(ada_next + (size_t)b * 9216 + 1024 + c) + 1.0f; }
        else { sh[j] = (f32x4){0.f, 0.f, 0.f, 0.f}; sc[j] = sh[j]; } }
    f32x4 nv32[4]; h16x4 nv16[4]; v2u nfw[4];
#define LN_LOAD(rr) do { const size_t row_ = (size_t)(r_begin + (rr)); \
        if (hin32) { _Pragma("unroll") for (int j = 0; j < 4; ++j) nv32[j] = *(const GAS f32x4*)(hin32 + row_ * DM + 4 * lane + 256 * j); } \
        else { _Pragma("unroll") for (int j = 0; j < 4; ++j) nv16[j] = *(const GAS h16x4*)(hin16 + row_ * DM + 4 * lane + 256 * j); } \
        if (do_ln) { _Pragma("unroll") for (int j = 0; j < 4; ++j) nfw[j] = *(const GAS v2u*)(Fs + (row_ - row0) * DM + 4 * lane + 256 * j); } } while (0)
    LN_LOAD(0);
    for (int r = 0; r < rpw; ++r) {
        const size_t row = (size_t)(r_begin + r);
        f32x4 v[4]; v2u fwc[4];
#pragma unroll
        for (int j = 0; j < 4; ++j) { v[j] = hin32 ? nv32[j] : (f32x4){(float)nv16[j].x, (float)nv16[j].y, (float)nv16[j].z, (float)nv16[j].w}; fwc[j] = nfw[j]; }
        if (r + 1 < rpw) LN_LOAD(r + 1);
        if (do_ln) {
            float s = 0.f;
#pragma unroll
            for (int j = 0; j < 4; ++j) { const v2u fw = fwc[j];
                const f32x4 f = (f32x4){bflo(fw.x), bfhi(fw.x), bflo(fw.y), bfhi(fw.y)};
                v[j] = v[j] * DN_ALPHA + ga[j] * f; s += (v[j].x + v[j].y) + (v[j].z + v[j].w); }
            const float mean = wave_sum(s, lane) * (1.f / DM); float s2 = 0.f;
#pragma unroll
            for (int j = 0; j < 4; ++j) { v[j] = v[j] - mean; s2 += (v[j].x * v[j].x + v[j].y * v[j].y) + (v[j].z * v[j].z + v[j].w * v[j].w); }
            const float rstd = 1.f / sqrtf(wave_sum(s2, lane) * (1.f / DM) + LN_EPS);
#pragma unroll
            for (int j = 0; j < 4; ++j) v[j] = v[j] * rstd * lg[j] + lb[j];
            if (hout32) {
#pragma unroll
                for (int j = 0; j < 4; ++j) *(GAS f32x4*)(hout32 + row * DM + 4 * lane + 256 * j) = v[j];
            } else {
#pragma unroll
                for (int j = 0; j < 4; ++j) { h16x4 hv; hv.x = (_Float16)v[j].x; hv.y = (_Float16)v[j].y; hv.z = (_Float16)v[j].z; hv.w = (_Float16)v[j].w;
                    *(GAS h16x4*)(hout16 + row * DM + 4 * lane + 256 * j) = hv;
                    v[j] = (f32x4){(float)hv.x, (float)hv.y, (float)hv.z, (float)hv.w}; }
            }
        }
        if (hm) {
#pragma unroll
            for (int j = 0; j < 4; ++j) { const f32x4 o = v[j] * sc[j] + sh[j]; v2u w; w.x = pk2(o.x, o.y); w.y = pk2(o.z, o.w);
                *(GAS v2u*)(hm + row * DM + 4 * lane + 256 * j) = w; }
        }
    }
}
#undef LN_LOAD

__device__ __forceinline__ void phase_rope_tables(Frame& F, const int* positions, float* cstab, float* sntab) {
    const int gt = F.bid * (NWAVES * 64) + F.tid, NT = F.G * NWAVES * 64;
    for (int i = gt; i < MALL * 16; i += NT) { const float ang = (float)positions[i >> 4] * exp2f(-(float)(i & 15) * (13.287712379549449f / 16.0f)); cstab[i] = cosf(ang); sntab[i] = sinf(ang); }
}
__device__ __forceinline__ void phase_prep(Frame& F, const bf16* __restrict__ proj, const bf16* __restrict__ qraw, const bf16* __restrict__ kvraw, const float* __restrict__ cstab, const float* __restrict__ sntab, int tok0, bf16* __restrict__ qf, bf16* __restrict__ kf, bf16* __restrict__ vf) {
    typedef float f32x2v __attribute__((ext_vector_type(2)));
    const int gw = F.bid * NWAVES + F.wave, NGW = F.G * NWAVES, lane = F.lane, hd = lane >> 3, li = lane & 7;
    const float SC = 0.10206207261596575f * LOG2E;
#pragma unroll 2
    for (int row = gw; row < CHROWS; row += NGW) {
        const bf16* pr = proj + (size_t)row * NINP; const bf16* qr = qraw + (size_t)row * 768 + hd * 96; const bf16* kr = kvraw + (size_t)row * 1024 + hd * 128;
        const unsigned qa0 = *(const GAS unsigned*)(pr + C_QA + 6 * lane), qa1 = *(const GAS unsigned*)(pr + C_QA + 6 * lane + 2), qa2 = *(const GAS unsigned*)(pr + C_QA + 6 * lane + 4);
        const v2u ka = *(const GAS v2u*)(pr + C_KVA + 4 * lane);
        const unsigned kt1 = *(const GAS unsigned*)(pr + C_KR + 2 * li), kt2 = *(const GAS unsigned*)(pr + C_KR + 16 + 2 * li);
        const v4u qn = *(const GAS v4u*)(qr + 8 * li); const unsigned qt1 = *(const GAS unsigned*)(qr + 64 + 2 * li), qt2 = *(const GAS unsigned*)(qr + 80 + 2 * li);
        const v4u kn = *(const GAS v4u*)(kr + 8 * li), vv = *(const GAS v4u*)(kr + 64 + 8 * li);
        const f32x2v c2 = *(const GAS f32x2v*)(cstab + (size_t)(tok0 + row) * 16 + 2 * li), s2 = *(const GAS f32x2v*)(sntab + (size_t)(tok0 + row) * 16 + 2 * li);
        float sq = bflo(qa0) * bflo(qa0) + bfhi(qa0) * bfhi(qa0) + bflo(qa1) * bflo(qa1) + bfhi(qa1) * bfhi(qa1) + bflo(qa2) * bflo(qa2) + bfhi(qa2) * bfhi(qa2);
        float sk = bflo(ka.x) * bflo(ka.x) + bfhi(ka.x) * bfhi(ka.x) + bflo(ka.y) * bflo(ka.y) + bfhi(ka.y) * bfhi(ka.y);
        const float rq = rsqrtf(wave_sum(sq, lane) * (1.f / QR) + RMS_EPS) * SC, rk = rsqrtf(wave_sum(sk, lane) * (1.f / KVR) + RMS_EPS);
        bf16* qo = qf + (size_t)row * 768 + hd * 96; bf16* ko = kf + (size_t)row * 768 + hd * 96; bf16* vo = vf + (size_t)row * 512 + hd * 64;
        v4u o;
        o.x = pk2(bflo(qn.x) * rq, bfhi(qn.x) * rq); o.y = pk2(bflo(qn.y) * rq, bfhi(qn.y) * rq); o.z = pk2(bflo(qn.z) * rq, bfhi(qn.z) * rq); o.w = pk2(bflo(qn.w) * rq, bfhi(qn.w) * rq);
        *(GAS v4u*)(qo + 8 * li) = o;
        { const float a0 = bflo(qt1), a1 = bfhi(qt1), b0 = bflo(qt2), b1 = bfhi(qt2);
          *(GAS unsigned*)(qo + 64 + 2 * li) = pk2((a0 * c2.x - b0 * s2.x) * rq, (a1 * c2.y - b1 * s2.y) * rq);
          *(GAS unsigned*)(qo + 80 + 2 * li) = pk2((b0 * c2.x + a0 * s2.x) * rq, (b1 * c2.y + a1 * s2.y) * rq); }
        o.x = pk2(bflo(kn.x) * rk, bfhi(kn.x) * rk); o.y = pk2(bflo(kn.y) * rk, bfhi(kn.y) * rk); o.z = pk2(bflo(kn.z) * rk, bfhi(kn.z) * rk); o.w = pk2(bflo(kn.w) * rk, bfhi(kn.w) * rk);
        *(GAS v4u*)(ko + 8 * li) = o;
        { const float a0 = bflo(kt1), a1 = bfhi(kt1), b0 = bflo(kt2), b1 = bfhi(kt2);
          *(GAS unsigned*)(ko + 64 + 2 * li) = pk2(a0 * c2.x - b0 * s2.x, a1 * c2.y - b1 * s2.y);
          *(GAS unsigned*)(ko + 80 + 2 * li) = pk2(b0 * c2.x + a0 * s2.x, b1 * c2.y + a1 * s2.y); }
        o.x = pk2(bflo(vv.x) * rk, bfhi(vv.x) * rk); o.y = pk2(bflo(vv.y) * rk, bfhi(vv.y) * rk); o.z = pk2(bflo(vv.z) * rk, bfhi(vv.z) * rk); o.w = pk2(bflo(vv.w) * rk, bfhi(vv.w) * rk);
        *(GAS v4u*)(vo + 8 * li) = o;
    }
}

__device__ __forceinline__ void phase_dilmerge(Frame& F, const bf16* __restrict__ og, const float* __restrict__ lse2, bf16* __restrict__ ydil) {
    const int gw = F.bid * NWAVES + F.wave, NGW = F.G * NWAVES, lane = F.lane, slot = lane >> 4;
#pragma unroll 2
    for (int row = gw; row < CHROWS; row += NGW) {
        float l0 = lse2[(size_t)0 * CHROWS * 4 + (size_t)row * 4 + slot], l1 = lse2[(size_t)1 * CHROWS * 4 + (size_t)row * 4 + slot], l2 = lse2[(size_t)2 * CHROWS * 4 + (size_t)row * 4 + slot];
        const float mx = fmaxf(l0, fmaxf(l1, l2)); float w0 = exp2f(l0 - mx), w1 = exp2f(l1 - mx), w2 = exp2f(l2 - mx); const float inv = 1.0f / (w0 + w1 + w2); w0 *= inv; w1 *= inv; w2 *= inv;
        const v4u a = *(const GAS v4u*)(og + (size_t)0 * CHROWS * 512 + (size_t)row * 512 + 8 * lane), b = *(const GAS v4u*)(og + (size_t)1 * CHROWS * 512 + (size_t)row * 512 + 8 * lane), c = *(const GAS v4u*)(og + (size_t)2 * CHROWS * 512 + (size_t)row * 512 + 8 * lane);
        v4u o;
        o.x = pk2(w0 * bflo(a.x) + w1 * bflo(b.x) + w2 * bflo(c.x), w0 * bfhi(a.x) + w1 * bfhi(b.x) + w2 * bfhi(c.x));
        o.y = pk2(w0 * bflo(a.y) + w1 * bflo(b.y) + w2 * bflo(c.y), w0 * bfhi(a.y) + w1 * bfhi(b.y) + w2 * bfhi(c.y));
        o.z = pk2(w0 * bflo(a.z) + w1 * bflo(b.z) + w2 * bflo(c.z), w0 * bfhi(a.z) + w1 * bfhi(b.z) + w2 * bfhi(c.z));
        o.w = pk2(w0 * bflo(a.w) + w1 * bflo(b.w) + w2 * bflo(c.w), w0 * bfhi(a.w) + w1 * bfhi(b.w) + w2 * bfhi(c.w));
        *(GAS v4u*)(ydil + (size_t)row * 512 + 8 * lane) = o;
    }
}

template <int DK, int DV>
__device__ __forceinline__ void attn_unit_ref(Frame& F, const bf16* Qp, const bf16* Kp, long rs, const bf16* Vp, long rs_v, bf16* Op, long rs_o, float* Lp, long rs_l,
                                              int qpos0, int klo, int khi, int band, float scale2, float slope2) {
    constexpr int DKP = DK / 4, DVP = DV / 4;
    LAS unsigned char* Ks = F.lds;
    LAS unsigned char* Vs = F.lds + 64 * DK * 2;
    const int tid = F.tid, part = tid & 3, qi = tid >> 2, qpos = qpos0 + qi;
    float qv[DKP], ov[DVP];
#pragma unroll
    for (int e8 = 0; e8 < DKP / 8; ++e8) { const v4u w = *(const GAS v4u*)(Qp + (long)qpos * rs + part * DKP + e8 * 8);
        qv[e8 * 8 + 0] = bflo(w.x); qv[e8 * 8 + 1] = bfhi(w.x); qv[e8 * 8 + 2] = bflo(w.y); qv[e8 * 8 + 3] = bfhi(w.y);
        qv[e8 * 8 + 4] = bflo(w.z); qv[e8 * 8 + 5] = bfhi(w.z); qv[e8 * 8 + 6] = bflo(w.w); qv[e8 * 8 + 7] = bfhi(w.w); }
#pragma unroll
    for (int e = 0; e < DVP; ++e) ov[e] = 0.f;
    float m = -1e30f, l = 0.f;
    for (int kt = klo; kt < khi; kt += 64) {
        for (int c = tid; c < 64 * DK / 8; c += NWAVES * 64) { const int j = c / (DK / 8), cc = c % (DK / 8); const int kp = kt + j;
            v4u w = (v4u){0u, 0u, 0u, 0u}; if (kp >= 0) w = *(const GAS v4u*)(Kp + (long)kp * rs + cc * 8);
            *(LAS v4u*)(Ks + (j * DK + cc * 8) * 2) = w; }
        for (int c = tid; c < 64 * DV / 8; c += NWAVES * 64) { const int j = c / (DV / 8), cc = c % (DV / 8); const int kp = kt + j;
            v4u w = (v4u){0u, 0u, 0u, 0u}; if (kp >= 0) w = *(const GAS v4u*)(Vp + (long)kp * rs_v + cc * 8);
            *(LAS v4u*)(Vs + (j * DV + cc * 8) * 2) = w; }
        __syncthreads();
        for (int j = 0; j < 64; ++j) {
            const int kp = kt + j, dist = qpos - kp;
            float d = 0.f;
#pragma unroll
            for (int e8 = 0; e8 < DKP / 8; ++e8) { const v4u w = *(const LAS v4u*)(Ks + (j * DK + part * DKP + e8 * 8) * 2);
                d += qv[e8 * 8 + 0] * bflo(w.x) + qv[e8 * 8 + 1] * bfhi(w.x) + qv[e8 * 8 + 2] * bflo(w.y) + qv[e8 * 8 + 3] * bfhi(w.y)
                   + qv[e8 * 8 + 4] * bflo(w.z) + qv[e8 * 8 + 5] * bfhi(w.z) + qv[e8 * 8 + 6] * bflo(w.w) + qv[e8 * 8 + 7] * bfhi(w.w); }
            d += lane_xor(d, 1, tid & 63); d += lane_xor(d, 2, tid & 63);
            const bool valid = (kp >= 0) && (dist >= 0) && (dist <= band);
            if (valid) {
                const float s = d * scale2 - slope2 * (float)dist;
                const float mn = fmaxf(m, s), a = exp2f(m - mn), p = exp2f(s - mn);
                l = l * a + p; m = mn;
#pragma unroll
                for (int e8 = 0; e8 < DVP / 8; ++e8) { const v4u w = *(const LAS v4u*)(Vs + (j * DV + part * DVP + e8 * 8) * 2);
                    ov[e8 * 8 + 0] = ov[e8 * 8 + 0] * a + p * bflo(w.x); ov[e8 * 8 + 1] = ov[e8 * 8 + 1] * a + p * bfhi(w.x);
                    ov[e8 * 8 + 2] = ov[e8 * 8 + 2] * a + p * bflo(w.y); ov[e8 * 8 + 3] = ov[e8 * 8 + 3] * a + p * bfhi(w.y);
                    ov[e8 * 8 + 4] = ov[e8 * 8 + 4] * a + p * bflo(w.z); ov[e8 * 8 + 5] = ov[e8 * 8 + 5] * a + p * bfhi(w.z);
                    ov[e8 * 8 + 6] = ov[e8 * 8 + 6] * a + p * bflo(w.w); ov[e8 * 8 + 7] = ov[e8 * 8 + 7] * a + p * bfhi(w.w); }
            }
        }
        __syncthreads();
    }
    const float inv = 1.0f / l;
#pragma unroll
    for (int e8 = 0; e8 < DVP / 8; ++e8) { v4u w; w.x = pk2(ov[e8 * 8 + 0] * inv, ov[e8 * 8 + 1] * inv); w.y = pk2(ov[e8 * 8 + 2] * inv, ov[e8 * 8 + 3] * inv);
        w.z = pk2(ov[e8 * 8 + 4] * inv, ov[e8 * 8 + 5] * inv); w.w = pk2(ov[e8 * 8 + 6] * inv, ov[e8 * 8 + 7] * inv);
        *(GAS v4u*)(Op + (long)qpos * rs_o + part * DVP + e8 * 8) = w; }
    if (Lp && part == 0) Lp[(long)qpos * rs_l] = m + log2f(l);
}

__device__ __forceinline__ void phase_dilated_ref(Frame& F, const bf16* proj, bf16* og, float* lse2) {
    for (int u = F.bid; u < CHB * 3 * 4 * 32; u += F.G) {
        const int jq = u & 31, hh = (u >> 5) & 3, g = (u >> 7) % 3, b = u / 384;
        const int d = (g == 0) ? 1 : (g == 1) ? 4 : 16, bpr = 32 / d, r = jq / bpr, j = jq % bpr;
        const int head = g * 4 + hh;
        const float slope = exp2f(-8.0f * (float)(head + 1) / 12.0f);
        const bf16* Qp = proj + ((size_t)b * SEQ + r) * NINP + C_DIL + head * 128;
        bf16* Op = og + (size_t)g * CHROWS * 512 + ((size_t)b * SEQ + r) * 512 + hh * 128;
        float* Lp = lse2 + (size_t)g * CHROWS * 4 + ((size_t)b * SEQ + r) * 4 + hh;
        attn_unit_ref<128, 128>(F, Qp, Qp + 1536, (long)NINP * d, Qp + 3072, (long)NINP * d, Op, 512L * d, Lp, 4L * d,
                                128 * j, 128 * j - 128, 128 * j + 128, 128, 0.08838834764831845f * LOG2E, slope * (float)d * LOG2E);
    }
}
__device__ __forceinline__ void phase_mla_ref(Frame& F, const bf16* qf, const bf16* kf, const bf16* vf, bf16* ymla) {
    const int nun = CHB * 8 * 32;
    for (int i = 0; F.bid + i * F.G < nun; ++i) {
        int bh, jb;
        if (F.G == 256) { const int s = F.bid & 7; bh = F.bid >> 3; jb = (i == 0) ? s : (i == 1) ? 15 - s : (i == 2) ? 16 + s : 31 - s; }
        else { const int t = F.bid + i * F.G; bh = t >> 5; jb = t & 31; }
        const int b = bh >> 3, h = bh & 7;
        attn_unit_ref<96, 64>(F, qf + (size_t)b * SEQ * 768 + h * 96, kf + (size_t)b * SEQ * 768 + h * 96, 768L, vf + (size_t)b * SEQ * 512 + h * 64, 512L,
                              ymla + (size_t)b * SEQ * 512 + h * 64, 512L, nullptr, 0L, 128 * jb, 0, 128 * jb + 128, 1 << 30, 1.0f, 0.0f);
    }
}

__device__ __forceinline__ float gelu_tanh(float x) { const float t = 0.7978845608028654f * (x + 0.044715f * x * x * x); const float e = __expf(2.0f * t); const float th = 1.0f - 2.0f / (e + 1.0f); return 0.5f * x * (1.0f + th); }


namespace fa {
typedef float f32x16 __attribute__((ext_vector_type(16)));
typedef short s16x4 __attribute__((ext_vector_type(4)));
typedef short v4i16_t __attribute__((ext_vector_type(4)));
typedef float f32x2_t __attribute__((ext_vector_type(2))); typedef __bf16 bf16x2_t __attribute__((ext_vector_type(2)));
__device__ __forceinline__ unsigned cvtpk(float lo, float hi) { f32x2_t v = {lo, hi}; bf16x2_t b = __builtin_convertvector(v, bf16x2_t); return __builtin_bit_cast(unsigned, b); }
__device__ __forceinline__ s16x4 vtr(const LAS unsigned char* p) { return __builtin_bit_cast(s16x4, __builtin_amdgcn_ds_read_tr16_b64_v4i16((LAS v4i16_t*)p)); }
__device__ __forceinline__ float xhalf_other(float m) { unsigned a = __builtin_bit_cast(unsigned, m), b = a; asm volatile("" : "+v"(b));
    auto rr = __builtin_amdgcn_permlane32_swap(a, b, false, false); unsigned r0 = rr[0], r1 = rr[1]; asm volatile("" : "+v"(r0), "+v"(r1));
    return __builtin_bit_cast(float, r0) + __builtin_bit_cast(float, r1) - m; }
__device__ __forceinline__ float xhalf_max(float m) { unsigned a = __builtin_bit_cast(unsigned, m), b = a; asm volatile("" : "+v"(b));
    auto rr = __builtin_amdgcn_permlane32_swap(a, b, false, false); unsigned r0 = rr[0], r1 = rr[1]; asm volatile("" : "+v"(r0), "+v"(r1));
    return fmaxf(__builtin_bit_cast(float, r0), __builtin_bit_cast(float, r1)); }
__device__ __forceinline__ float xhalf_sum(float m) { unsigned a = __builtin_bit_cast(unsigned, m), b = a; asm volatile("" : "+v"(b));
    auto rr = __builtin_amdgcn_permlane32_swap(a, b, false, false); unsigned r0 = rr[0], r1 = rr[1]; asm volatile("" : "+v"(r0), "+v"(r1));
    return __builtin_bit_cast(float, r0) + __builtin_bit_cast(float, r1); }
__device__ __forceinline__ float max3f(float a, float b, float c) { float r; asm("v_max3_f32 %0, %1, %2, %3" : "=v"(r) : "v"(a), "v"(b), "v"(c)); return r; }
__device__ __forceinline__ float max2f(float a, float b) { float r; asm("v_max_f32_e32 %0, %1, %2" : "=v"(r) : "v"(a), "v"(b)); return r; }
constexpr int crowc(int r) { return (r & 3) + 8 * (r >> 2); }
constexpr float THR = 8.0f;

template <int DK, int DV, bool DIL>
__device__ __forceinline__ void attn_unit(Frame& F, const bf16* Qp, const bf16* Kp, long rs, const bf16* Vp, long rs_v, bf16* Op, long rs_o, float* Lp, long rs_l,
                                          int q0, int kt0, int ntiles, int band, float scale2, float slope2) {
    constexpr bool NEGM = !DIL;
    constexpr int KCH = DK / 8, VPC = (DV / 32) * 4, KBYTES = 64 * DK * 2, VBYTES = 64 * DV * 2, ND0 = DK / 16, NDB = DV / 32;
    constexpr int KOFF = 0, VOFF = 2 * KBYTES, WSF_OFF = 2 * KBYTES + 2 * VBYTES;
    static_assert(WSF_OFF + 1024 <= RING_BYTES && 8 * 32 * DV * 2 <= WSF_OFF, "attention LDS map");
    LAS unsigned char* lds = F.lds;
    const int lane = F.lane, w = F.wave, r32 = lane & 31, hi = lane >> 5;
    const int qw0 = q0 + 32 * w, qpos = qw0 + r32;
    LAS float* wsf = (LAS float*)(lds + WSF_OFF) + w * 32;
    bf16x8 qr[ND0];
#pragma unroll
    for (int d0 = 0; d0 < ND0; ++d0) qr[d0] = *(const GAS bf16x8*)(Qp + (long)qpos * rs + d0 * 16 + hi * 8);
    f32x16 o[NDB];
#pragma unroll
    for (int db = 0; db < NDB; ++db)
#pragma unroll
        for (int r = 0; r < 16; ++r) o[db][r] = 0.f;
    float m_run = -1e30f, l_run = 0.f, sh = 0.f;
    f32x16 negm; { float z0 = 0.f; asm volatile("" : "+v"(z0));
#pragma unroll
      for (int r = 0; r < 16; ++r) negm[r] = z0; }
    int t = 0; int kt = kt0;
    while (kt < 0 && t < ntiles) { kt += 64; ++t; }
#define FA_DMA(ktile, buf_) do { \
        _Pragma("unroll") for (int i = 0; i < 2; ++i) { const int c = w + 8 * i; if (c < KCH) __builtin_amdgcn_global_load_lds((const GAS unsigned*)(Kp + (long)((ktile) + lane) * rs + c * 8), (LAS unsigned*)(lds + KOFF + (buf_) * KBYTES + c * 1024), 16, 0, 0); } \
        _Pragma("unroll") for (int i = 0; i < 2; ++i) { const int pc_ = w + 8 * i; if (pc_ < VPC) __builtin_amdgcn_global_load_lds((const GAS unsigned*)(Vp + (long)((ktile) + (pc_ & 3) * 16 + (lane >> 2)) * rs_v + (pc_ >> 2) * 32 + (lane & 3) * 8), (LAS unsigned*)(lds + VOFF + (buf_) * VBYTES + pc_ * 1024), 16, 0, 0); } } while (0)
    if (t < ntiles) FA_DMA(kt, 0);
    __syncthreads();
    int buf = 0;
    for (; t < ntiles; ++t, kt += 64, buf ^= 1) {
        const bool has_next = (t + 1 < ntiles);
        if (has_next) FA_DMA(kt + 64, buf ^ 1);
        const bool skip = (kt > qw0 + 31) || (qw0 - (kt + 63) > band);
        if (!skip) {
            const bool need_mask = (qw0 - (kt + 63) < 0) || ((qw0 + 31) - kt > band);
            const LAS unsigned char* Kb = lds + KOFF + buf * KBYTES + hi * 1024 + r32 * 16;
            const LAS unsigned char* Vb = lds + VOFF + buf * VBYTES + ((lane >> 4) & 1) * 32 + (lane & 3) * 8 + (4 * hi + ((lane & 15) >> 2)) * 64;
            bf16x8 kfr[2 * ND0];
#pragma unroll
            for (int d0 = 0; d0 < ND0; ++d0) { kfr[2 * d0] = *(const LAS bf16x8*)(Kb + d0 * 2048); kfr[2 * d0 + 1] = *(const LAS bf16x8*)(Kb + d0 * 2048 + 512); }
            __builtin_amdgcn_sched_barrier(0);
            f32x16 p0, p1;
            const float shc = NEGM ? sh : 0.f;
            if constexpr (NEGM) {
#pragma unroll
                for (int d0 = 0; d0 < ND0; ++d0) {
                    p0 = __builtin_amdgcn_mfma_f32_32x32x16_bf16(kfr[2 * d0], qr[d0], d0 == 0 ? negm : p0, 0, 0, 0);
                    p1 = __builtin_amdgcn_mfma_f32_32x32x16_bf16(kfr[2 * d0 + 1], qr[d0], d0 == 0 ? negm : p1, 0, 0, 0);
                }
            } else {
#pragma unroll
                for (int r = 0; r < 16; ++r) { p0[r] = 0.f; p1[r] = 0.f; }
#pragma unroll
                for (int d0 = 0; d0 < ND0; ++d0) {
                    p0 = __builtin_amdgcn_mfma_f32_32x32x16_bf16(kfr[2 * d0], qr[d0], p0, 0, 0, 0);
                    p1 = __builtin_amdgcn_mfma_f32_32x32x16_bf16(kfr[2 * d0 + 1], qr[d0], p1, 0, 0, 0);
                }
            }
            asm volatile("s_nop 15\n\ts_nop 7" : "+v"(p0), "+v"(p1));
            if (DIL) {
                const float base0 = slope2 * (float)(kt + 4 * hi - qw0);
#pragma unroll
                for (int r = 0; r < 16; ++r) { p0[r] = p0[r] * scale2 + (base0 + slope2 * (float)crowc(r)); p1[r] = p1[r] * scale2 + (base0 + slope2 * (float)(crowc(r) + 32)); }
            }
            if (need_mask) {
                const int dq = qpos - kt - 4 * hi;
#pragma unroll
                for (int r = 0; r < 16; ++r) { const int d0_ = dq - crowc(r), d1_ = d0_ - 32;
                    p0[r] = ((unsigned)d0_ <= (unsigned)band) ? p0[r] : -1e30f; p1[r] = ((unsigned)d1_ <= (unsigned)band) ? p1[r] : -1e30f; }
            }
            float ra = max3f(p0[0], p0[1], p1[0]), rb = max3f(p0[2], p0[3], p1[1]); ra = max3f(ra, p1[2], p1[3]);
#pragma unroll
            for (int r = 4; r < 16; r += 4) { ra = max3f(ra, p0[r], p0[r + 1]); rb = max3f(rb, p0[r + 2], p0[r + 3]); ra = max3f(ra, p1[r], p1[r + 1]); rb = max3f(rb, p1[r + 2], p1[r + 3]); }
            const float rm = xhalf_max(max2f(ra, rb));
            if (__any(rm + shc > m_run + THR)) {
                const float mn = fmaxf(m_run, rm + shc), f = __builtin_amdgcn_exp2f(m_run - mn), dl = fmaxf(mn, -1e20f) - shc;
                l_run *= f; m_run = mn;
#pragma unroll
                for (int r = 0; r < 16; ++r) { p0[r] -= dl; p1[r] -= dl; }
                if (NEGM) { sh = mn;
#pragma unroll
                    for (int r = 0; r < 16; ++r) negm[r] = -mn; }
                if (hi == 0) wsf[r32] = f;
                asm volatile("" ::: "memory");
#pragma unroll
                for (int r = 0; r < 16; ++r) { const float fr_ = wsf[crowc(r) + 4 * hi];
#pragma unroll
                    for (int db = 0; db < NDB; ++db) o[db][r] *= fr_; }
            }
            else if (!NEGM) { const float mu = fmaxf(m_run, -1e20f);
#pragma unroll
                for (int r = 0; r < 16; ++r) { p0[r] -= mu; p1[r] -= mu; } }
            float ls = 0.f;
#pragma unroll
            for (int r = 0; r < 16; ++r) { p0[r] = __builtin_amdgcn_exp2f(p0[r]); p1[r] = __builtin_amdgcn_exp2f(p1[r]); ls += p0[r] + p1[r]; }
            l_run += ls;
            v4u pw[4];
#pragma unroll
            for (int s = 0; s < 2; ++s) {
                pw[s] = (v4u){cvtpk(p0[8 * s + 0], p0[8 * s + 1]), cvtpk(p0[8 * s + 2], p0[8 * s + 3]), cvtpk(p0[8 * s + 4], p0[8 * s + 5]), cvtpk(p0[8 * s + 6], p0[8 * s + 7])};
                pw[2 + s] = (v4u){cvtpk(p1[8 * s + 0], p1[8 * s + 1]), cvtpk(p1[8 * s + 2], p1[8 * s + 3]), cvtpk(p1[8 * s + 4], p1[8 * s + 5]), cvtpk(p1[8 * s + 6], p1[8 * s + 7])};
            }
#pragma unroll
            for (int db = 0; db < NDB; ++db) {
                s16x4 vlo[4], vhi[4];
#pragma unroll
                for (int ks = 0; ks < 4; ++ks) { vlo[ks] = vtr(Vb + (db * 4 + ks) * 1024); vhi[ks] = vtr(Vb + (db * 4 + ks) * 1024 + 512); }
                __builtin_amdgcn_sched_barrier(0);
#pragma unroll
                for (int ks = 0; ks < 4; ++ks) {
                    const bf16x8 vf = (bf16x8){vlo[ks][0], vlo[ks][1], vlo[ks][2], vlo[ks][3], vhi[ks][0], vhi[ks][1], vhi[ks][2], vhi[ks][3]};
                    o[db] = __builtin_amdgcn_mfma_f32_32x32x16_bf16(__builtin_bit_cast(bf16x8, pw[ks]), vf, o[db], 0, 0, 0);
                }
            }
        }
        __syncthreads();
    }
#undef FA_DMA
    const float l_tot = xhalf_sum(l_run);
    int lane_e = lane; asm volatile("" : "+v"(lane_e));
    if (hi == 0) wsf[r32] = l_tot;
    asm volatile("" ::: "memory");
    if (Lp && hi == 0) Lp[(long)qpos * rs_l] = m_run + log2f(l_tot) + (DIL ? slope2 * (float)(qw0 - qpos) : 0.f);
    LAS bf16* stg = (LAS bf16*)(lds + w * (32 * DV * 2));
#pragma unroll
    for (int r = 0; r < 16; ++r) { const int orow = crowc(r) + 4 * (lane_e >> 5); const float rl = 1.0f / wsf[orow];
#pragma unroll
        for (int db = 0; db < NDB; ++db) stg[orow * DV + db * 32 + (lane_e & 31)] = (bf16)f2bf(o[db][r] * rl); }
    asm volatile("s_waitcnt lgkmcnt(0)" ::: "memory");
#pragma unroll
    for (int i = 0; i < (32 * DV / 8) / 64; ++i) { const int id = i * 64 + lane_e, row = id / (DV / 8), ch = id % (DV / 8);
        const v4u v = *(const LAS v4u*)((const LAS unsigned char*)stg + row * (DV * 2) + ch * 16);
        *(GAS v4u*)(Op + (long)(qw0 + row) * rs_o + ch * 8) = v; }
    __syncthreads();
}
}

__device__ __forceinline__ void phase_dilated_mfma(Frame& F, const bf16* proj, bf16* og, float* lse2) {
    for (int u = F.bid; u < CHB * 3 * 4 * 16; u += F.G) {
        const int jq = u & 15, hh = (u >> 4) & 3, g = (u >> 6) % 3, b = u / 192;
        const int d = (g == 0) ? 1 : (g == 1) ? 4 : 16, bpr = 16 / d, r = jq / bpr, j = jq % bpr;
        const int head = g * 4 + hh;
        const float slope = exp2f(-8.0f * (float)(head + 1) / 12.0f);
        const bf16* Qp = proj + ((size_t)b * SEQ + r) * NINP + C_DIL + head * 128;
        bf16* Op = og + (size_t)g * CHROWS * 512 + ((size_t)b * SEQ + r) * 512 + hh * 128;
        float* Lp = lse2 + (size_t)g * CHROWS * 4 + ((size_t)b * SEQ + r) * 4 + hh;
        float sc2 = 0.08838834764831845f * LOG2E; asm volatile("" : "+v"(sc2));
        fa::attn_unit<128, 128, true>(F, Qp, Qp + 1536, (long)NINP * d, Qp + 3072, (long)NINP * d, Op, 512L * d, Lp, 4L * d,
                                      256 * j, 256 * j - 128, 6, 128, sc2, slope * (float)d * LOG2E);
    }
}
__device__ __forceinline__ void phase_mla_mfma(Frame& F, const bf16* qf, const bf16* kf, const bf16* vf, bf16* ymla) {
    for (int i = 0; i < 2; ++i) {
        const int s = F.bid & 7, bh = F.bid >> 3, qb = (i == 0) ? 15 - s : s, b = bh >> 3, h = bh & 7;
        fa::attn_unit<96, 64, false>(F, qf + (size_t)b * SEQ * 768 + h * 96, kf + (size_t)b * SEQ * 768 + h * 96, 768L, vf + (size_t)b * SEQ * 512 + h * 64, 512L,
                                     ymla + (size_t)b * SEQ * 512 + h * 64, 512L, nullptr, 0L, 256 * qb, 0, 4 * qb + 4, 1 << 30, 1.0f, 0.0f);
    }
}

#ifndef MK_MULTI
#define MK_MULTI 0
#endif
constexpr int NPHASES = 2 + DEPTH * (3 + NCHUNK * 7 + 3) + (DEPTH - 1);

__global__ void __launch_bounds__(NWAVES * 64, 2) fwd_kernel(Args args) {
    extern __shared__ __attribute__((aligned(16))) unsigned char lds[];
    Frame F;
    F.lds = (LAS unsigned char*)lds;
    F.tid = threadIdx.x; F.lane = F.tid & 63; F.wave = __builtin_amdgcn_readfirstlane(F.tid >> 6);
    F.G = 256; F.bid = blockIdx.x;
    const int bid0 = F.bid, wave0 = F.wave;
    unsigned char* ws = args.ws;
    gu32* ctl = (gu32*)(ws + WS_CTL);
    for (int u = F.tid; u < (LDS_BYTES - LDSCTL_OFF) / 4; u += NWAVES * 64) ((LAS unsigned*)(F.lds + LDSCTL_OFF))[u] = 0u;
    __syncthreads();
    (void)xcd_barrier_post((unsigned*)(ctl + CW_BAR), (volatile LAS unsigned*)(F.lds + MISC_OFF) + 8);
#define TID_NOW(ones_) ((wave0 << 6) | (int)__builtin_amdgcn_mbcnt_hi(ones_, __builtin_amdgcn_mbcnt_lo(ones_, 0u)))
#define GRID_BAR() do { size_t zofb_ = 0; asm volatile("" : "+s"(zofb_)); unsigned char* wsb = args.ws + zofb_; XcdBarrier bar_; bar_.bar = (unsigned*)(wsb + WS_CTL) + CW_BAR; bar_.x = xb_xcc_id(); bar_.st = (volatile LAS unsigned*)(F.lds + MISC_OFF) + 8; unsigned ones_b = ~0u; asm volatile("" : "+s"(ones_b)); xcd_barrier(bar_, TID_NOW(ones_b)); } while (0)
#if MK_MULTI
    const int lo = args.ph_lo, hi = args.ph_hi;
    int pc = 0;
#define SITE_BEGIN if (pc >= lo && pc < hi) { size_t zoff_ = 0; asm volatile("" : "+s"(zoff_)); unsigned char* wsl = args.ws + zoff_; F.bid = bid0; F.wave = wave0; asm volatile("" : "+s"(F.bid), "+s"(F.wave)); unsigned ones_s = ~0u; asm volatile("" : "+s"(ones_s)); F.tid = TID_NOW(ones_s); asm volatile("" : "+v"(F.tid)); F.lane = F.tid & 63;
#define SITE_END } ++pc;
#else
#define SITE_BEGIN { size_t zoff_ = 0; asm volatile("" : "+s"(zoff_)); unsigned char* wsl = args.ws + zoff_; F.bid = bid0; F.wave = wave0; asm volatile("" : "+s"(F.bid), "+s"(F.wave)); unsigned ones_s = ~0u; asm volatile("" : "+s"(ones_s)); F.tid = TID_NOW(ones_s); asm volatile("" : "+v"(F.tid)); F.lane = F.tid & 63;
#define SITE_END } GRID_BAR();
#endif
#ifdef PROF_SEL
#define PF_T0() ({ unsigned ones_p = ~0u; asm volatile("" : "+s"(ones_p)); TID_NOW(ones_p) == 0; })
#define PF_W() ({ size_t zofp_ = 0; asm volatile("" : "+s"(zofp_)); (unsigned long long*)(args.ws + zofp_ + WS_CTL + 768 * 1024); })
#define SITE_END_C(c) } { const bool pf_on = (PROF_SEL == 0) || (PROF_SEL == (c)); const unsigned long long pf_te = __builtin_amdgcn_s_memrealtime(); GRID_BAR(); \
        if (pf_on && PROF_WHAT == 0) { const unsigned long long pf_ta = __builtin_amdgcn_s_memrealtime(); if (PF_T0()) __hip_atomic_fetch_add(PF_W(), pf_ta - pf_te, __ATOMIC_RELAXED, __HIP_MEMORY_SCOPE_AGENT); } }
#else
#define SITE_END_C(c) SITE_END
#endif
#define REP_BEGIN(n) for (int rep_ = 0; rep_ < (n); ++rep_) { if (rep_) __syncthreads();
#define REP_END }
#ifndef REP_FFN
#define REP_FFN 1
#endif
#ifndef REP_C1
#define REP_C1 1
#endif
#ifndef REP_C2
#define REP_C2 1
#endif
#ifndef REP_C3
#define REP_C3 1
#endif
#ifndef REP_LN
#define REP_LN 1
#endif
#ifndef REP_C4
#define REP_C4 1
#endif
#ifndef REP_C56
#define REP_C56 1
#endif

#define x_in ((const float*)args.in[0])
#define positions ((const int*)args.in[2])
#define ada ((float*)(wsl + WS_ADA))
#define h (args.out)
#define hm ((bf16*)(wsl + WS_HM))
#define Fs_ffn ((bf16*)(wsl + WS_F_FFN))
#define Fs_mix ((bf16*)(wsl + WS_F_MIX))
#define h16 ((_Float16*)(wsl + WS_H16))
#define gbuf ((bf16*)(wsl + WS_G))
#define proj ((bf16*)(wsl + WS_PROJ))
#define qraw ((bf16*)(wsl + WS_QRAW))
#define kvraw ((bf16*)(wsl + WS_KVRAW))
#define qf ((bf16*)(wsl + WS_QF))
#define kf ((bf16*)(wsl + WS_KF))
#define vf ((bf16*)(wsl + WS_VF))
#define ys ((bf16*)(wsl + WS_YS))
#define y3 ((bf16*)(wsl + WS_Y3))
#define og ((bf16*)(wsl + WS_OG))
#define lse2 ((float*)(wsl + WS_LSE))
#define tb ((bf16*)(wsl + WS_T))
#define ug ((bf16*)(wsl + WS_UG))
#define wb ((const unsigned char*)(wsl + WS_W))
#define lng_all ((const float*)args.in[5])
#define lnb_all ((const float*)args.in[6])
#define ada_l (ada + (size_t)l * 16 * 9216)
    for (int l = 0; l < DEPTH; ++l) {
        SITE_BEGIN
#ifndef SKIP_ADA
            if (l == 0) { phase_ada(F, (const float*)args.in[1], (const float*)args.in[3], (const float*)args.in[4], ada); phase_rope_tables(F, positions, (float*)(wsl + WS_ROPE), (float*)(wsl + WS_ROPE) + (size_t)MALL * 16); }
#endif
#ifndef SKIP_WCONV
            phase_wconv(F, args, l);
#endif
#ifdef DUP_WCONV
            phase_wconv(F, args, l);
#endif
        SITE_END_C(1)
        if (l == 0) {
            SITE_BEGIN
                phase_lnmod(F, false, x_in, nullptr, nullptr, nullptr, nullptr, hm, 0, MALL, nullptr, 0.f, nullptr, nullptr, ada + 0);
            SITE_END_C(2)
        }
        for (int half = 0; half < 2; ++half) {
            const int s = half * 2;
            SITE_BEGIN
            REP_BEGIN(REP_FFN)
                if (half == 0) phase_ssm_weights(F, wsl);
#ifdef DUP_WCONV
                if (half == 0) phase_ssm_weights(F, wsl);
#endif
                pg8::Gemm g{hm, (const bf16*)(wb + W_13 + half * W_13_SZ), MALL, 2 * DFF, DM, DM, DM, 0, 0};
                pg8::StaticOrder S; S.init(MALL, 2 * DFF, F.G, F.bid);
                pg8::EpiSwiGLU E{gbuf, DFF};
                pg8::gemm_phase<pg8::EpiSwiGLU, pg8::StaticOrder, true, true>(F.lds + RING_OFF, g, S, E, F.tid);
            REP_END
            SITE_END_C(3)
            SITE_BEGIN
            REP_BEGIN(REP_FFN)
                pg8::Gemm g{gbuf, (const bf16*)(wb + W_2 + half * W_2_SZ), MALL, DM, DFF, DFF, DFF, 0, 0};
                pg8::StaticOrder S; S.init(MALL, DM, F.G, F.bid);
                pg8::EpiStore E{Fs_ffn, DM, nullptr};
                pg8::gemm_phase<pg8::EpiStore, pg8::StaticOrder, true, true>(F.lds + RING_OFF, g, S, E, F.tid);
            REP_END
            SITE_END_C(4)
            SITE_BEGIN
                const bool last = (l == DEPTH - 1) && (half == 1);
                const bool first = (l == 0 && half == 0);
                const float* ada_next = (half == 0) ? ada_l + 1 * 3072 : ada_l + (size_t)16 * 9216 + 0;
                phase_lnmod(F, true, first ? x_in : nullptr, first ? nullptr : h16, Fs_ffn, last ? h : nullptr, last ? nullptr : h16, last ? nullptr : hm, 0, MALL, ada_l + s * 3072 + 2048, 0.5f, lng_all + ((size_t)l * 3 + s) * DM, lnb_all + ((size_t)l * 3 + s) * DM, ada_next);
            SITE_END_C(5)
            if (half == 1) break;
            for (int c = 0; c < NCHUNK; ++c) {
                const int tok0 = c * CHROWS;
                SITE_BEGIN
                REP_BEGIN(REP_C1)
                    pg8::Gemm g{hm + (size_t)tok0 * DM, (const bf16*)(wb + W_IN), CHROWS, NINP, DM, DM, DM, 0, 0};
                    pg8::StaticOrder S; S.init(CHROWS, NINP, F.G, F.bid);
                    pg8::EpiInProj E{proj, NINP, (const float*)(wsl + WS_SMALL + SM_BIAS), ug, C_U / 256, SSM_NR, SSM_KE};
                    pg8::gemm_phase<pg8::EpiInProj, pg8::StaticOrder, true, true>(F.lds + RING_OFF, g, S, E, F.tid);
                REP_END
                SITE_END_C(6)
                SITE_BEGIN
                REP_BEGIN(REP_C2)
                    { pg8::Gemm g{proj + C_QA, (const bf16*)(wb + W_QB), CHROWS, 768, QR, NINP, QR, 0, 0};
                      pg8::StaticOrder S; S.init(CHROWS, 768, F.G, F.bid);
                      pg8::EpiStore E{qraw, 768, nullptr};
                      pg8::gemm_phase<pg8::EpiStore, pg8::StaticOrder, true, true>(F.lds + RING_OFF, g, S, E, F.tid); }
#ifdef DUP_Q
                    __syncthreads();
                    { pg8::Gemm g{proj + C_QA, (const bf16*)(wb + W_QB), CHROWS, 768, QR, NINP, QR, 0, 0};
                      pg8::StaticOrder S; S.init(CHROWS, 768, F.G, F.bid);
                      pg8::EpiStore E{qraw, 768, nullptr};
                      pg8::gemm_phase<pg8::EpiStore, pg8::StaticOrder, true, true>(F.lds + RING_OFF, g, S, E, F.tid); }
#endif
                    { pg8::Gemm g{proj + C_KVA, (const bf16*)(wb + W_KVB), CHROWS, 1024, KVR, NINP, KVR, 0, 0};
                      pg8::StaticOrder S; S.init(CHROWS, 1024, F.G, F.bid);
                      pg8::EpiStore E{kvraw, 1024, nullptr};
                      pg8::gemm_phase<pg8::EpiStore, pg8::StaticOrder, true, true>(F.lds + RING_OFF, g, S, E, F.tid); }
#ifdef DUP_KV
                    __syncthreads();
                    { pg8::Gemm g{proj + C_KVA, (const bf16*)(wb + W_KVB), CHROWS, 1024, KVR, NINP, KVR, 0, 0};
                      pg8::StaticOrder S; S.init(CHROWS, 1024, F.G, F.bid);
                      pg8::EpiStore E{kvraw, 1024, nullptr};
                      pg8::gemm_phase<pg8::EpiStore, pg8::StaticOrder, true, true>(F.lds + RING_OFF, g, S, E, F.tid); }
#endif
                    { pg8::Gemm g{ug, (const bf16*)(wb + W_SS), 32 * SSM_NR, 256, 256, SSM_KE, 256, 0, 0, 4, 256L * 256};
                      pg8::StaticOrder S; S.init(32 * SSM_NR, 256, F.G, F.bid);
                      pg8::EpiSsmState E{ug, (const float*)(wsl + WS_SMALL + SM_DEC), SSM_KE};
                      pg8::gemm_phase<pg8::EpiSsmState, pg8::StaticOrder, false, true>(F.lds + RING_OFF, g, S, E, F.tid); }
#ifdef DUP_ST
                    __syncthreads();
                    { pg8::Gemm g{ug, (const bf16*)(wb + W_SS), 32 * SSM_NR, 256, 256, SSM_KE, 256, 0, 0, 4, 256L * 256};
                      pg8::StaticOrder S; S.init(32 * SSM_NR, 256, F.G, F.bid);
                      pg8::EpiSsmState E{ug, (const float*)(wsl + WS_SMALL + SM_DEC), SSM_KE};
                      pg8::gemm_phase<pg8::EpiSsmState, pg8::StaticOrder, false, true>(F.lds + RING_OFF, g, S, E, F.tid); }
#endif
                    __syncthreads();
                    phase_dilated_mfma(F, proj, og, lse2);
#ifdef DUP_DIL
                    __syncthreads(); phase_dilated_mfma(F, proj, og, lse2);
#endif
                REP_END
                SITE_END_C(7)
                SITE_BEGIN
                REP_BEGIN(REP_C3)
#ifndef SKIP_PREP
                    phase_prep(F, proj, qraw, kvraw, (const float*)(wsl + WS_ROPE), (const float*)(wsl + WS_ROPE) + (size_t)MALL * 16, tok0, qf, kf, vf);
#ifdef DUP_PREP
                    phase_prep(F, proj, qraw, kvraw, (const float*)(wsl + WS_ROPE), (const float*)(wsl + WS_ROPE) + (size_t)MALL * 16, tok0, qf, kf, vf);
#endif
#endif
                    phase_dilmerge(F, og, lse2, y3 + (size_t)1 * CHROWS * 512);
#ifdef DUP_DM
                    phase_dilmerge(F, og, lse2, y3 + (size_t)1 * CHROWS * 512);
#endif
                    { pg8::Gemm g{ug, (const bf16*)(wb + W_SM), 32 * SSM_NR, 256, SSM_KE, SSM_KE, SSM_KE, 0, 0, 4, 256L * SSM_KE};
                      pg8::StaticOrder S; S.init(32 * SSM_NR, 256, F.G, F.bid);
                      pg8::EpiSsmMain E{ys, 512, ug, SSM_KE, SSM_NR, (const float*)args.in[23] + l * 512};
                      pg8::gemm_phase<pg8::EpiSsmMain, pg8::StaticOrder, true, true>(F.lds + RING_OFF, g, S, E, F.tid); }
#ifdef DUP_SM
                    __syncthreads();
                    { pg8::Gemm g{ug, (const bf16*)(wb + W_SM), 32 * SSM_NR, 256, SSM_KE, SSM_KE, SSM_KE, 0, 0, 4, 256L * SSM_KE};
                      pg8::StaticOrder S; S.init(32 * SSM_NR, 256, F.G, F.bid);
                      pg8::EpiSsmMain E{ys, 512, ug, SSM_KE, SSM_NR, (const float*)args.in[23] + l * 512};
                      pg8::gemm_phase<pg8::EpiSsmMain, pg8::StaticOrder, true, true>(F.lds + RING_OFF, g, S, E, F.tid); }
#endif
                REP_END
                SITE_END_C(8)
                SITE_BEGIN
                REP_BEGIN(REP_C4)
                    phase_mla_mfma(F, qf, kf, vf, y3);
                    __syncthreads();
                    { pg8::Gemm g{ys, (const bf16*)(wb + W_GLU), CHROWS, 512, 512, 512, 512, 0, 0};
                      pg8::StaticOrder S; S.init(CHROWS, 512, F.G, F.bid);
                      pg8::EpiGLU E{y3 + (size_t)2 * CHROWS * 512, 512, ys, 512, (const float*)args.in[25] + l * 512};
                      pg8::gemm_phase<pg8::EpiGLU, pg8::StaticOrder, true, true>(F.lds + RING_OFF, g, S, E, F.tid); }
#ifdef DUP_GLU
                    __syncthreads();
                    { pg8::Gemm g{ys, (const bf16*)(wb + W_GLU), CHROWS, 512, 512, 512, 512, 0, 0};
                      pg8::StaticOrder S; S.init(CHROWS, 512, F.G, F.bid);
                      pg8::EpiGLU E{y3 + (size_t)2 * CHROWS * 512, 512, ys, 512, (const float*)args.in[25] + l * 512};
                      pg8::gemm_phase<pg8::EpiGLU, pg8::StaticOrder, true, true>(F.lds + RING_OFF, g, S, E, F.tid); }
#endif
                REP_END
                SITE_END_C(9)
                SITE_BEGIN
                REP_BEGIN(REP_C56)
                    pg8::Gemm g{y3, (const bf16*)(wb + W_BR), CHROWS, 3072, 512, 512, 512, 4, (long)CHROWS * 512};
                    pg8::BranchOrder S; S.init(CHROWS, F.G, F.bid);
                    pg8::EpiGateAcc E{(float*)tb, tb + (size_t)CHROWS * 2048, DM, proj + C_GATE, NINP};
                    pg8::gemm_phase<pg8::EpiGateAcc, pg8::BranchOrder, true, true>(F.lds + RING_OFF, g, S, E, F.tid);
                REP_END
                SITE_END_C(10)
                SITE_BEGIN
                REP_BEGIN(REP_C56)
                    pg8::Gemm g{tb + (size_t)CHROWS * 2048, (const bf16*)(wb + W_OUT), CHROWS, DM, DM, DM, DM, 0, 0};
                    pg8::StaticOrder S; S.init(CHROWS, DM, F.G, F.bid);
                    pg8::EpiStore E{Fs_mix, DM, nullptr};
                    pg8::gemm_phase<pg8::EpiStore, pg8::StaticOrder, true, true>(F.lds + RING_OFF, g, S, E, F.tid);
                REP_END
                SITE_END_C(11)
                SITE_BEGIN
                    phase_lnmod(F, true, nullptr, h16, Fs_mix, nullptr, h16, hm, tok0, CHROWS, ada_l + 1 * 3072 + 2048, 1.0f, lng_all + ((size_t)l * 3 + 1) * DM, lnb_all + ((size_t)l * 3 + 1) * DM, ada_l + 2 * 3072);
                SITE_END_C(12)
            }
        }
    }
#ifdef PROF_SEL
    { GRID_BAR();
      if (bid0 == 0 && PF_T0()) { const unsigned long long tot = __hip_atomic_load(PF_W(), __ATOMIC_RELAXED, __HIP_MEMORY_SCOPE_AGENT); const unsigned long long dl = tot / 256;
          const unsigned long long t0 = __builtin_amdgcn_s_memrealtime(); while (__builtin_amdgcn_s_memrealtime() - t0 < dl) __builtin_amdgcn_s_sleep(8); } }
#endif
#undef SITE_BEGIN
#undef SITE_END
#undef x_in
#undef positions
#undef ada
#undef h
#undef hm
#undef Fs_ffn
#undef Fs_mix
#undef h16
#undef gbuf
#undef proj
#undef qraw
#undef kvraw
#undef qf
#undef kf
#undef vf
#undef ys
#undef y3
#undef og
#undef lse2
#undef tb
#undef ug
#undef wb
#undef lng_all
#undef lnb_all
#undef ada_l
}

extern "C" void kernel_launch(void* const* d_in, const int* in_sizes, int n_in, void* d_out, int out_size, void* d_ws, size_t ws_size, hipStream_t stream) {
    static int grid = 0;
    if (grid == 0) {
        if (n_in != 28 || in_sizes[0] != MALL * DM || out_size != MALL * DM || ws_size < WS_END || ws_size < WS_G + (size_t)MALL * DFF * 2) {
            fprintf(stderr, "kernel_launch: unexpected problem shape (n_in %d, in0 %d, out %d, ws %zu); nothing launched\n", n_in, n_in > 0 ? in_sizes[0] : -1, out_size, ws_size); grid = -1; return; }
        int dev = 0, cus = 0, per_cu = 0;
        if (hipGetDevice(&dev) != hipSuccess || hipDeviceGetAttribute(&cus, hipDeviceAttributeMultiprocessorCount, dev) != hipSuccess) { grid = -1; return; }
        if (hipFuncSetAttribute((const void*)fwd_kernel, hipFuncAttributeMaxDynamicSharedMemorySize, LDS_BYTES) != hipSuccess) { fprintf(stderr, "kernel_launch: hipFuncSetAttribute failed\n"); grid = -1; return; }
        if (hipOccupancyMaxActiveBlocksPerMultiprocessor(&per_cu, (const void*)fwd_kernel, NWAVES * 64, LDS_BYTES) != hipSuccess || per_cu < 1)
            fprintf(stderr, "kernel_launch: note: occupancy query reports %d workgroups per CU\n", per_cu);
        (void)hipGetLastError();
        grid = cus;
        if (grid != 256) { fprintf(stderr, "kernel_launch: built for a 256-CU device, found %d CUs; nothing launched\n", cus); grid = -1; return; }
    }
    if (grid < 0) return;
    if (hipMemsetAsync((char*)d_ws + WS_CTL, 0, CTL_ZERO_BYTES, stream) != hipSuccess) return;
    Args a{};
    for (int i = 0; i < 28; ++i) a.in[i] = d_in[i];
    a.out = (float*)d_out; a.ws = (unsigned char*)d_ws;
#if MK_MULTI
    for (int p = 0; p < NPHASES; ++p) { a.ph_lo = p; a.ph_hi = p + 1; hipLaunchKernelGGL(fwd_kernel, dim3(grid), dim3(NWAVES * 64), LDS_BYTES, stream, a); }
#else
    a.ph_lo = 0; a.ph_hi = NPHASES;
    hipLaunchKernelGGL(fwd_kernel, dim3(grid), dim3(NWAVES * 64), LDS_BYTES, stream, a);
#endif
    const hipError_t le = hipPeekAtLastError();
    if (le != hipSuccess) fprintf(stderr, "kernel_launch: launch failed: %s\n", hipGetErrorName(le));
}
```

```cpp
#include <hip/hip_runtime.h>
#include <cstdio>
#include <cstdint>
#include <cmath>
namespace pg8 {
#define PG8_LAS __attribute__((address_space(3)))
typedef unsigned short bf16_t;
typedef short bf16x8 __attribute__((ext_vector_type(8)));
typedef float f32x4 __attribute__((ext_vector_type(4)));
typedef unsigned u32x4 __attribute__((ext_vector_type(4)));
constexpr int BM = 256, BK = 64, HALF = 128, HTB = HALF * BK * 2  , STAGE_BYTES = 8 * HTB, NXCD = 8, WGM = 8;

__host__ __device__ __forceinline__ int lds_byte(int r, int c) { const int st = (r >> 4) * 2 + (c >> 5), rr = r & 15, cc = c & 31, ob = rr * 64 + cc * 2; return st * 1024 + (ob ^ (((ob >> 9) & 1) << 5)); }
__host__ __device__ __forceinline__ void stage_rc(int b, int& R, int& C) { const int st = b / 1024, sb = b % 1024, swz = sb ^ (((sb >> 9) & 1) << 5); R = (st >> 1) * 16 + swz / 64; C = (st & 1) * 32 + (swz % 64) / 2; }
__host__ __device__ __forceinline__ int perm32(int rho) { const int n = rho >> 4, i = rho & 15; return 8 * (i >> 2) + 4 * n + (i & 3); }

struct Unit { int pm, pn; };
struct Gemm { const bf16_t* A; const bf16_t* Bt; int M, N, K; int lda, ldb; int asplit; long astride; int bsplit; long bstride; };

struct StaticOrder {
    int nM, nN, nwg, G, c;
    __host__ __device__ void init(int M, int N, int G_, int c_) { nM = M / BM; nN = N / BM; nwg = nM * nN; G = G_; c = c_; }
    __host__ __device__ bool next(int i, Unit& u) const {
        const long L = (long)i * G + c; if (L >= nwg) return false;
        int wgid = (int)L; { const int q = nwg / NXCD, r = nwg % NXCD, xcd = wgid % NXCD, off = wgid / NXCD; wgid = (xcd < r ? xcd * (q + 1) : r * (q + 1) + (xcd - r) * q) + off; }
        const int nig = WGM * nN, gid = wgid / nig, fm = gid * WGM, gsz = (nM - fm) < WGM ? (nM - fm) : WGM;
        u.pm = fm + ((wgid % nig) % gsz); u.pn = (wgid % nig) / gsz; return true;
    }
    __device__ __forceinline__ void a_ready(const Unit&) const {}
    __device__ __forceinline__ void done(const Unit&) const {}
};

__device__ __forceinline__ unsigned cvt_pk_bf16(float lo, float hi) { unsigned r; asm volatile("v_cvt_pk_bf16_f32 %0, %1, %2" : "=v"(r) : "v"(lo), "v"(hi)); return r; }
typedef float f32x2 __attribute__((ext_vector_type(2)));
__device__ __forceinline__ f32x2 gelu_pk(f32x2 v) {
    const f32x2 av = __builtin_elementwise_abs(v), d = av * 0.2316418882f + 1.0f;
    f32x2 t; t.x = __builtin_amdgcn_rcpf(d.x); t.y = __builtin_amdgcn_rcpf(d.y);
    f32x2 q = t * 0.5307027145f + (-0.7265760135f); q = q * t + 0.7107068705f; q = q * t + (-0.142248368f); q = q * t + 0.127414796f; q = q * t;
    const f32x2 s = (v * v) * (-0.72134752044f);
    f32x2 e; e.x = __builtin_amdgcn_exp2f(s.x); e.y = __builtin_amdgcn_exp2f(s.y);
    const f32x2 m = v * (q * e), r = v - m;
    f32x2 o; o.x = v.x < 0.f ? m.x : r.x; o.y = v.y < 0.f ? m.y : r.y; return o;
}

template <int ACT  > struct EpiBf16 {
    static constexpr bool PERM = true, AFTER_DRAIN = false; static_assert(ACT == 0 || ACT == 1, "EpiBf16: ACT is 0 (none) or 1 (gelu_pk)");
    bf16_t* O; int ldc; const float* bias; int split_cols; size_t split_stride; float scale0;
    __device__ __forceinline__ void operator()(const f32x4 (&acc)[2][2][4][2], const Unit& u, int wr, int wc, int fr, int fq) const {
        const int row0 = u.pm * BM + wr * 64 + fr; int colt = u.pn * BM; bf16_t* base = O;
        float sc = 1.f; if (split_cols) { const int t = colt / split_cols; base += (size_t)t * split_stride; colt -= t * split_cols; if (t == 0) sc = scale0; }
        const int col0 = colt + wc * 32 + 8 * fq, bcol0 = u.pn * BM + wc * 32 + 8 * fq;
        f32x4 bv[2][2];
#pragma unroll
        for (int bj = 0; bj < 2; ++bj)
#pragma unroll
            for (int n = 0; n < 2; ++n) bv[bj][n] = bias ? *(const f32x4*)(bias + bcol0 + bj * HALF + 4 * n) : (f32x4){0.f, 0.f, 0.f, 0.f};
#pragma unroll
        for (int ai = 0; ai < 2; ++ai)
#pragma unroll
            for (int m = 0; m < 4; ++m) { bf16_t* rowp = base + (size_t)(row0 + ai * HALF + m * 16) * ldc + col0;
#pragma unroll
                for (int bj = 0; bj < 2; ++bj) { f32x4 v0 = acc[ai][bj][m][0] + bv[bj][0], v1 = acc[ai][bj][m][1] + bv[bj][1];
                    if (ACT == 1) { f32x2 a = gelu_pk((f32x2){v0[0], v0[1]}), b = gelu_pk((f32x2){v0[2], v0[3]}), c = gelu_pk((f32x2){v1[0], v1[1]}), d = gelu_pk((f32x2){v1[2], v1[3]});
                        v0 = (f32x4){a.x, a.y, b.x, b.y}; v1 = (f32x4){c.x, c.y, d.x, d.y}; }
                    v0 = v0 * sc; v1 = v1 * sc; u32x4 w; w.x = cvt_pk_bf16(v0[0], v0[1]); w.y = cvt_pk_bf16(v0[2], v0[3]); w.z = cvt_pk_bf16(v1[0], v1[1]); w.w = cvt_pk_bf16(v1[2], v1[3]);
                    *(u32x4*)(rowp + bj * HALF) = w; } }
    }
};

struct PanelStats {
    unsigned* xbuf;
    unsigned* cnt;
    unsigned* tmo;
    int ntn; float eps;
    unsigned code;
    __device__ __forceinline__ bool run(const f32x4 (&v)[2][2][4][2], const Unit& u, int wr, int wc, int fr, int fq, PG8_LAS unsigned char* lds, int wid, int lane) const {
        typedef float f32x2v __attribute__((ext_vector_type(2)));
        PG8_LAS f32x2v* P = (PG8_LAS f32x2v*)lds;
        PG8_LAS f32x2v* S = (PG8_LAS f32x2v*)(lds + 8192);
        PG8_LAS unsigned* flag = (PG8_LAS unsigned*)(lds + 8192 + 2048);
#pragma unroll
        for (int ai = 0; ai < 2; ++ai)
#pragma unroll
            for (int m = 0; m < 4; ++m) {
                float s = 0.f;
#pragma unroll
                for (int bj = 0; bj < 2; ++bj)
#pragma unroll
                    for (int n = 0; n < 2; ++n) { const f32x4 x = v[ai][bj][m][n]; s += (x[0] + x[1]) + (x[2] + x[3]); }
                s += __shfl_xor(s, 16); s += __shfl_xor(s, 32);
                const float mw = s * (1.0f / 64.0f); float q = 0.f;
#pragma unroll
                for (int bj = 0; bj < 2; ++bj)
#pragma unroll
                    for (int n = 0; n < 2; ++n) { const f32x4 d = v[ai][bj][m][n] - mw; q += (d[0] * d[0] + d[1] * d[1]) + (d[2] * d[2] + d[3] * d[3]); }
                q += __shfl_xor(q, 16); q += __shfl_xor(q, 32);
                if (fq == 0) P[(ai * HALF + wr * 64 + m * 16 + fr) * 4 + wc] = (f32x2v){mw, q};
            }
        asm volatile("s_waitcnt lgkmcnt(0)" ::: "memory"); __builtin_amdgcn_s_barrier(); asm volatile("" ::: "memory");
#if defined(BROKEN_EXCHANGE_NO_WAIT)
#warning BROKEN CONTROL BUILD: the row-statistics exchange does not wait; results are wrong by design
        if (blockIdx.x >= 64) { const long long t0_ = clock64(); while (clock64() - t0_ < 60000) __builtin_amdgcn_s_sleep(8); }
#endif
        const int row = wid * 32 + (lane & 31);
        if (lane < 32) {
            const f32x2v a = P[row * 4 + 0], b = P[row * 4 + 1], c = P[row * 4 + 2], d = P[row * 4 + 3];
            const float mt = (a.x + b.x + c.x + d.x) * 0.25f;
            const float da = a.x - mt, db = b.x - mt, dc = c.x - mt, dd = d.x - mt;
            const float m2 = (a.y + b.y) + (c.y + d.y) + 64.0f * ((da * da + db * db) + (dc * dc + dd * dd));
            unsigned long long* slot = (unsigned long long*)xbuf + ((size_t)(u.pm * BM + row) * 4 + u.pn);
            __hip_atomic_store(slot, ((unsigned long long)__float_as_uint(m2) << 32) | __float_as_uint(mt), __ATOMIC_RELAXED, __HIP_MEMORY_SCOPE_AGENT);
        }
        asm volatile("s_waitcnt vmcnt(0)" ::: "memory");
        if (lane == 0) __hip_atomic_fetch_add(cnt + 64 * u.pm, 1u, __ATOMIC_RELAXED, __HIP_MEMORY_SCOPE_AGENT);
        if (wid == 0) {
            bool dead = false; const unsigned long long t0 = __builtin_amdgcn_s_memrealtime(); const unsigned want = 8u * (unsigned)ntn;
            for (;;) {
#if defined(BROKEN_EXCHANGE_NO_WAIT)
                break;
#endif
                if ((unsigned)__builtin_amdgcn_readfirstlane(__hip_atomic_load(cnt + 64 * u.pm, __ATOMIC_RELAXED, __HIP_MEMORY_SCOPE_AGENT)) >= want) break;
                if (__builtin_amdgcn_s_memrealtime() - t0 > 2000000ull) {
                    if (lane == 0) { unsigned expect = 0u; __hip_atomic_compare_exchange_strong(tmo + 1, &expect, code | (unsigned)(u.pm & 0xff), __ATOMIC_RELAXED, __ATOMIC_RELAXED, __HIP_MEMORY_SCOPE_AGENT);
                                     __hip_atomic_store(tmo, 1u, __ATOMIC_RELAXED, __HIP_MEMORY_SCOPE_AGENT); }
                    dead = true; break; }
                __builtin_amdgcn_s_sleep(2);
            }
            __builtin_amdgcn_fence(__ATOMIC_ACQUIRE, "agent");
            if (lane == 0) flag[0] = dead ? 1u : 0u;
        }
        asm volatile("s_waitcnt vmcnt(0) lgkmcnt(0)" ::: "memory"); __builtin_amdgcn_s_barrier(); asm volatile("" ::: "memory");
        const bool bad = flag[0] != 0u;
        if (lane < 32) {
            const unsigned long long* slot = (const unsigned long long*)xbuf + (size_t)(u.pm * BM + row) * 4; float mt[4], m2[4]; float ms = 0.f;
#pragma unroll
            for (int t = 0; t < 4; ++t) { if (t < ntn) { const unsigned long long w = __hip_atomic_load(slot + t, __ATOMIC_RELAXED, __HIP_MEMORY_SCOPE_AGENT); mt[t] = __uint_as_float((unsigned)w); m2[t] = __uint_as_float((unsigned)(w >> 32)); } else { mt[t] = 0.f; m2[t] = 0.f; } ms += mt[t]; }
            const float mean = ms / (float)ntn; float q = 0.f;
#pragma unroll
            for (int t = 0; t < 4; ++t) if (t < ntn) { const float dm = mt[t] - mean; q += m2[t] + 256.0f * dm * dm; }
            S[row] = (f32x2v){mean, 1.0f / sqrtf(q / (256.0f * (float)ntn) + eps)};
        }
        asm volatile("s_waitcnt lgkmcnt(0)" ::: "memory"); __builtin_amdgcn_s_barrier(); asm volatile("" ::: "memory");
        return bad;
    }
};
struct EpiLnRes {
    static constexpr bool PERM = false, AFTER_DRAIN = true;
    const float* base; float* out; int ldc; const float* bias; PanelStats st; unsigned poison;
    __device__ __forceinline__ void fused(f32x4 (&acc)[2][2][4][2], const Unit& u, int wr, int wc, int fr, int fq, PG8_LAS unsigned char* lds, int wid, int lane) const {
        typedef float f32x2v __attribute__((ext_vector_type(2)));
        const PG8_LAS f32x2v* S = (const PG8_LAS f32x2v*)(lds + 8192);
        const int col0 = u.pn * BM + wc * 32 + 4 * fq;
#pragma unroll
        for (int bj = 0; bj < 2; ++bj)
#pragma unroll
            for (int n = 0; n < 2; ++n) { const f32x4 bv = bias ? *(const f32x4*)(bias + col0 + bj * HALF + n * 16) : (f32x4){0.f, 0.f, 0.f, 0.f};
#pragma unroll
                for (int ai = 0; ai < 2; ++ai)
#pragma unroll
                    for (int m = 0; m < 4; ++m) acc[ai][bj][m][n] += bv; }
        f32x4 pre[4][2][2];
#pragma unroll
        for (int m = 0; m < 4; ++m) { const size_t off = (size_t)(u.pm * BM + wr * 64 + m * 16 + fr) * ldc + col0;
#pragma unroll
            for (int bj = 0; bj < 2; ++bj)
#pragma unroll
                for (int n = 0; n < 2; ++n) pre[m][bj][n] = *(const f32x4*)(base + off + bj * HALF + n * 16); }
        const bool bad = st.run(acc, u, wr, wc, fr, fq, lds, wid, lane) || poison != 0u;
        const float qnan = __builtin_nanf("");
#pragma unroll
        for (int ai = 0; ai < 2; ++ai)
#pragma unroll
            for (int m = 0; m < 4; ++m) { const int r = ai * HALF + wr * 64 + m * 16 + fr; const f32x2v sr = S[r]; const size_t off = (size_t)(u.pm * BM + r) * ldc + col0;
#pragma unroll
                for (int bj = 0; bj < 2; ++bj)
#pragma unroll
                    for (int n = 0; n < 2; ++n) { const f32x4 bs = ai == 0 ? pre[m][bj][n] : *(const f32x4*)(base + off + bj * HALF + n * 16); f32x4 o = bs + (acc[ai][bj][m][n] - sr.x) * sr.y;
                        if (bad) o = (f32x4){qnan, qnan, qnan, qnan}; *(f32x4*)(out + off + bj * HALF + n * 16) = o; }
                if (m & 1) asm volatile("" ::: "memory"); }
    }
};
struct EpiLnResLn {
    static constexpr bool PERM = false, AFTER_DRAIN = true;
    const float* base; float* out; bf16_t* xn; int ldc; const float* bias; PanelStats st1, st2; unsigned poison;
    __device__ __forceinline__ void fused(f32x4 (&acc)[2][2][4][2], const Unit& u, int wr, int wc, int fr, int fq, PG8_LAS unsigned char* lds, int wid, int lane) const {
        typedef float f32x2v __attribute__((ext_vector_type(2))); typedef unsigned u32x2v __attribute__((ext_vector_type(2)));
        const PG8_LAS f32x2v* S = (const PG8_LAS f32x2v*)(lds + 8192);
        const int col0 = u.pn * BM + wc * 32 + 4 * fq;
#pragma unroll
        for (int bj = 0; bj < 2; ++bj)
#pragma unroll
            for (int n = 0; n < 2; ++n) { const f32x4 bv = bias ? *(const f32x4*)(bias + col0 + bj * HALF + n * 16) : (f32x4){0.f, 0.f, 0.f, 0.f};
#pragma unroll
                for (int ai = 0; ai < 2; ++ai)
#pragma unroll
                    for (int m = 0; m < 4; ++m) acc[ai][bj][m][n] += bv; }
        bool bad = st1.run(acc, u, wr, wc, fr, fq, lds, wid, lane) || poison != 0u;
        const float qnan = __builtin_nanf("");
#pragma unroll
        for (int ai = 0; ai < 2; ++ai)
#pragma unroll
            for (int m = 0; m < 4; ++m) { const int r = ai * HALF + wr * 64 + m * 16 + fr; const f32x2v sr = S[r]; const size_t off = (size_t)(u.pm * BM + r) * ldc + col0;
#pragma unroll
                for (int bj = 0; bj < 2; ++bj)
#pragma unroll
                    for (int n = 0; n < 2; ++n) { const f32x4 bs = *(const f32x4*)(base + off + bj * HALF + n * 16); acc[ai][bj][m][n] = bs + (acc[ai][bj][m][n] - sr.x) * sr.y; }
                asm volatile("" : "+v"(acc[ai][0][m][0]), "+v"(acc[ai][0][m][1]), "+v"(acc[ai][1][m][0]), "+v"(acc[ai][1][m][1]));
                if (m & 1) asm volatile("" ::: "memory"); }
        const bool bad1 = bad;
        bad = st2.run(acc, u, wr, wc, fr, fq, lds, wid, lane) || bad;
#pragma unroll
        for (int ai = 0; ai < 2; ++ai)
#pragma unroll
            for (int m = 0; m < 4; ++m) { const int r = ai * HALF + wr * 64 + m * 16 + fr; const f32x2v sr = S[r]; const size_t off = (size_t)(u.pm * BM + r) * ldc + col0;
#pragma unroll
                for (int bj = 0; bj < 2; ++bj)
#pragma unroll
                    for (int n = 0; n < 2; ++n) { const f32x4 x1 = acc[ai][bj][m][n]; *(f32x4*)(out + off + bj * HALF + n * 16) = bad1 ? (f32x4){qnan, qnan, qnan, qnan} : x1;
                        const f32x4 o = (x1 - sr.x) * sr.y; u32x2v w; w.x = cvt_pk_bf16(o[0], o[1]); w.y = cvt_pk_bf16(o[2], o[3]);
                        if (bad) { w.x = 0x7fc07fc0u; w.y = 0x7fc07fc0u; } *(u32x2v*)(xn + off + bj * HALF + n * 16) = w; }
                asm volatile("" ::: "memory"); }
    }
};

template <class Epi, class Sched, bool ALIGN_EPI = false, bool SP2 = false>
__device__ __forceinline__ void gemm_phase(PG8_LAS unsigned char* lds, const Gemm g, const Sched& S, const Epi& E, int tid_in) {
    int tid_ = tid_in; asm volatile("" : "+v"(tid_));
    const int tid = tid_, wid = __builtin_amdgcn_readfirstlane(tid >> 6), lane = tid & 63, wr = wid >> 2, wc = wid & 3, fr = lane & 15, fq = lane >> 4;
    const int K = g.K, nt = K / BK;
    unsigned voffA[2], voffB[2];
#pragma unroll
    for (int i = 0; i < 2; ++i) { int R, C; stage_rc(tid * 16 + i * 8192, R, C); const int Rb = Epi::PERM ? ((R & ~31) + perm32(R & 31)) : R;
        voffA[i] = (unsigned)(R * g.lda + C) * 2u; voffB[i] = (unsigned)(Rb * g.ldb + C) * 2u; }
    const size_t kstep = (size_t)(BK * 2);
    const size_t hstepA = (size_t)HALF * g.lda * 2, hstepB = (size_t)HALF * g.ldb * 2;
    const size_t tstepA = 2 * hstepA, tstepB = 2 * hstepB;
#define PG8_UA(u) ((const char*)g.A + (size_t)(u).pm * tstepA + (g.asplit ? (size_t)((u).pn / g.asplit) * (size_t)g.astride * 2 : (size_t)0))
#define PG8_UB(u) ((const char*)g.Bt + (size_t)(u).pn * tstepB + (g.bsplit ? (size_t)((u).pm / g.bsplit) * (size_t)g.bstride * 2 : (size_t)0))
    const unsigned ldsw = (unsigned)wid * 1024u;
    const int aoff = lds_byte(wr * 64 + fr, fq * 8), boff = lds_byte(wc * 32 + fr, fq * 8);
#define PG8_SA(b, h) (((b) * 2 + (h)) * HTB)
#define PG8_SB(b, h) ((4 + (b) * 2 + (h)) * HTB)
#define PG8_STAGE(bufoff, gbase, voff) do { _Pragma("unroll") for (int _i = 0; _i < 2; ++_i) \
        __builtin_amdgcn_global_load_lds((const unsigned*)((const char*)(gbase) + (voff)[_i]), (PG8_LAS unsigned*)(lds + (bufoff) + ldsw + _i * 8192), 16, 0, 0); } while (0)
#define PG8_LDA(dst, b, h) do { _Pragma("unroll") for (int m = 0; m < 4; ++m) _Pragma("unroll") for (int k = 0; k < 2; ++k) dst[m][k] = *(const PG8_LAS bf16x8*)(lds + PG8_SA(b, h) + aoff + m * 2048 + k * 1024); } while (0)
#define PG8_LDB(dst, b, h) do { _Pragma("unroll") for (int n = 0; n < 2; ++n) _Pragma("unroll") for (int k = 0; k < 2; ++k) dst[n][k] = *(const PG8_LAS bf16x8*)(lds + PG8_SB(b, h) + boff + n * 2048 + k * 1024); } while (0)
#define PG8_MMA(ai, bj, At, Bt) do { __builtin_amdgcn_s_setprio(1); _Pragma("unroll") for (int m = 0; m < 4; ++m) _Pragma("unroll") for (int n = 0; n < 2; ++n) _Pragma("unroll") for (int k = 0; k < 2; ++k) \
        acc[ai][bj][m][n] = __builtin_amdgcn_mfma_f32_16x16x32_bf16(Bt[n][k], At[m][k], acc[ai][bj][m][n], 0, 0, 0); __builtin_amdgcn_s_setprio(0); } while (0)
#define PG8_WAIT_V(n) asm volatile("s_waitcnt vmcnt(" #n ")" ::: "memory")
#define PG8_WAIT_L(n) asm volatile("s_waitcnt lgkmcnt(" #n ")" ::: "memory")
#define PG8_BAR __builtin_amdgcn_s_barrier()
#define PG8_SCHED __builtin_amdgcn_sched_barrier(0)
    Unit cur, nxt; int ui = 0;
    if (!S.next(0, cur)) return;
    f32x4 acc[2][2][4][2];
#pragma unroll
    for (int a = 0; a < 2; ++a)
#pragma unroll
        for (int b = 0; b < 2; ++b)
#pragma unroll
            for (int m = 0; m < 4; ++m)
#pragma unroll
                for (int n = 0; n < 2; ++n) acc[a][b][m][n] = (f32x4){0.f, 0.f, 0.f, 0.f};
    bf16x8 At[4][2], B0[2][2], B1[2][2];
    const char* cA = PG8_UA(cur); const char* cB = PG8_UB(cur);
    S.a_ready(cur);
    if constexpr (SP2) {
        PG8_STAGE(PG8_SB(0, 0), cB, voffB); PG8_STAGE(PG8_SB(0, 1), cB + hstepB, voffB); PG8_STAGE(PG8_SA(0, 0), cA, voffA); PG8_STAGE(PG8_SA(0, 1), cA + hstepA, voffA);
        if (wr == 1) PG8_BAR;
        PG8_WAIT_V(2); PG8_BAR;
        PG8_STAGE(PG8_SB(1, 0), cB + kstep, voffB); PG8_STAGE(PG8_SA(1, 0), cA + kstep, voffA); PG8_STAGE(PG8_SB(1, 1), cB + hstepB + kstep, voffB);
        PG8_WAIT_V(6); PG8_BAR;
    } else {
        PG8_STAGE(PG8_SB(0, 0), cB, voffB); PG8_STAGE(PG8_SA(0, 0), cA, voffA); PG8_STAGE(PG8_SB(0, 1), cB + hstepB, voffB); PG8_STAGE(PG8_SA(0, 1), cA + hstepA, voffA);
        if (wr == 1) PG8_BAR;
        PG8_WAIT_V(4); PG8_BAR;
        PG8_STAGE(PG8_SB(1, 0), cB + kstep, voffB); PG8_STAGE(PG8_SA(1, 0), cA + kstep, voffA); PG8_STAGE(PG8_SB(1, 1), cB + hstepB + kstep, voffB);
        PG8_WAIT_V(6); PG8_BAR;
    }
    for (;;) {
        const bool has_next = S.next(ui + 1, nxt);
        const char* nA = has_next ? PG8_UA(nxt) : cA; const char* nB = has_next ? PG8_UB(nxt) : cB;
        for (int t = 0; t < nt; t += 2) {
            const bool last = (t == nt - 2);
            const char* a1 = cA + (size_t)(t + 1) * kstep;
            const char* a2 = last ? nA : cA + (size_t)(t + 2) * kstep; const char* b2 = last ? nB : cB + (size_t)(t + 2) * kstep;
            const char* a3 = a2 + kstep; const char* b3 = b2 + kstep;
            if (last && has_next) S.a_ready(nxt);
            if constexpr (SP2) {
            PG8_LDB(B0, 0, 0); PG8_LDB(B1, 0, 1); PG8_SCHED; PG8_LDA(At, 0, 0); PG8_STAGE(PG8_SA(1, 1), a1 + hstepA, voffA);
            PG8_WAIT_V(8); PG8_WAIT_L(0); PG8_BAR; PG8_MMA(0, 0, At, B0); PG8_MMA(0, 1, At, B1); PG8_BAR; PG8_SCHED;
            PG8_LDA(At, 0, 1); PG8_STAGE(PG8_SB(0, 0), b2, voffB); PG8_STAGE(PG8_SB(0, 1), b2 + hstepB, voffB); PG8_STAGE(PG8_SA(0, 0), a2, voffA);
            PG8_WAIT_V(8); PG8_WAIT_L(0); PG8_BAR; PG8_MMA(1, 0, At, B0); PG8_MMA(1, 1, At, B1); PG8_BAR; PG8_SCHED;
            PG8_LDB(B0, 1, 0); PG8_LDB(B1, 1, 1); PG8_SCHED; PG8_LDA(At, 1, 0); PG8_STAGE(PG8_SA(0, 1), a2 + hstepA, voffA);
            PG8_WAIT_V(8); PG8_WAIT_L(0); PG8_BAR; PG8_MMA(0, 0, At, B0); PG8_MMA(0, 1, At, B1); PG8_BAR; PG8_SCHED;
            PG8_LDA(At, 1, 1); PG8_STAGE(PG8_SB(1, 0), b3, voffB); PG8_STAGE(PG8_SB(1, 1), b3 + hstepB, voffB); PG8_STAGE(PG8_SA(1, 0), a3, voffA);
            PG8_WAIT_V(8); PG8_WAIT_L(0); PG8_BAR; PG8_MMA(1, 0, At, B0); PG8_MMA(1, 1, At, B1); PG8_BAR; PG8_SCHED;
            } else {
            PG8_LDB(B0, 0, 0); PG8_SCHED; PG8_LDA(At, 0, 0); PG8_STAGE(PG8_SA(1, 1), a1 + hstepA, voffA);
            PG8_WAIT_L(8); PG8_BAR; PG8_WAIT_L(0); PG8_MMA(0, 0, At, B0); PG8_BAR; PG8_SCHED;
            PG8_LDB(B1, 0, 1); PG8_STAGE(PG8_SB(0, 0), b2, voffB);
            PG8_BAR; PG8_WAIT_L(0); PG8_MMA(0, 1, At, B1); PG8_BAR;
            PG8_LDA(At, 0, 1); PG8_STAGE(PG8_SA(0, 0), a2, voffA);
            PG8_BAR; PG8_WAIT_L(0); PG8_MMA(1, 0, At, B0); PG8_BAR; PG8_SCHED;
            PG8_STAGE(PG8_SB(0, 1), b2 + hstepB, voffB);
            PG8_WAIT_V(6); PG8_BAR; PG8_MMA(1, 1, At, B1); PG8_BAR;
            PG8_LDB(B0, 1, 0); PG8_SCHED; PG8_LDA(At, 1, 0); PG8_STAGE(PG8_SA(0, 1), a2 + hstepA, voffA);
            PG8_WAIT_L(8); PG8_BAR; PG8_WAIT_L(0); PG8_MMA(0, 0, At, B0); PG8_BAR; PG8_SCHED;
            PG8_LDB(B1, 1, 1); PG8_STAGE(PG8_SB(1, 0), b3, voffB);
            PG8_BAR; PG8_WAIT_L(0); PG8_MMA(0, 1, At, B1); PG8_BAR;
            PG8_LDA(At, 1, 1); PG8_STAGE(PG8_SA(1, 0), a3, voffA);
            PG8_BAR; PG8_WAIT_L(0); PG8_MMA(1, 0, At, B0); PG8_BAR; PG8_SCHED;
            PG8_STAGE(PG8_SB(1, 1), b3 + hstepB, voffB);
            PG8_WAIT_V(6); PG8_BAR; PG8_MMA(1, 1, At, B1); PG8_BAR;
            }
        }
        if constexpr (ALIGN_EPI) { if (wr == 0) PG8_BAR; }
        if constexpr (!Epi::AFTER_DRAIN) { E(acc, cur, wr, wc, fr, fq); S.done(cur); }
        if (!has_next) break;
#pragma unroll
        for (int a = 0; a < 2; ++a)
#pragma unroll
            for (int b = 0; b < 2; ++b)
#pragma unroll
                for (int m = 0; m < 4; ++m)
#pragma unroll
                    for (int n = 0; n < 2; ++n) acc[a][b][m][n] = (f32x4){0.f, 0.f, 0.f, 0.f};
        cur = nxt; cA = nA; cB = nB; ++ui;
        if constexpr (ALIGN_EPI) { if (wr == 1) PG8_BAR; }
    }
    PG8_WAIT_V(0);
    if constexpr (!ALIGN_EPI) { if (wr == 0) PG8_BAR; }
    PG8_BAR;
    if constexpr (Epi::AFTER_DRAIN) { E.fused(acc, cur, wr, wc, fr, fq, lds, wid, lane); S.done(cur); }
#undef PG8_SA
#undef PG8_SB
#undef PG8_STAGE
#undef PG8_LDA
#undef PG8_LDB
#undef PG8_MMA
#undef PG8_WAIT_V
#undef PG8_WAIT_L
#undef PG8_BAR
#undef PG8_SCHED
#undef PG8_UA
#undef PG8_UB
}
}
namespace pg8 {
__device__ __forceinline__ float sigmoid_fast(float x) { return __builtin_amdgcn_rcpf(1.0f + __builtin_amdgcn_exp2f(-1.4426950408889634f * x)); }
__device__ __forceinline__ float bf_lo(unsigned w) { return __builtin_bit_cast(float, w << 16); }
__device__ __forceinline__ float bf_hi(unsigned w) { return __builtin_bit_cast(float, w & 0xffff0000u); }
struct EpiStore {
    static constexpr bool PERM = true, AFTER_DRAIN = false;
    bf16_t* O; int ldc; const float* bias;
    __device__ __forceinline__ void operator()(const f32x4 (&acc)[2][2][4][2], const Unit& u, int wr, int wc, int fr_, int fq_) const {
        int fr = fr_, fq = fq_; asm volatile("" : "+v"(fr), "+v"(fq));
        const int row0 = u.pm * BM + wr * 64 + fr, col0 = u.pn * BM + wc * 32 + 8 * fq;
        f32x4 bv[2][2];
#pragma unroll
        for (int bj = 0; bj < 2; ++bj)
#pragma unroll
            for (int n = 0; n < 2; ++n) bv[bj][n] = bias ? *(const f32x4*)(bias + col0 + bj * HALF + 4 * n) : (f32x4){0.f, 0.f, 0.f, 0.f};
#pragma unroll
        for (int ai = 0; ai < 2; ++ai)
#pragma unroll
            for (int m = 0; m < 4; ++m) { bf16_t* rowp = O + (size_t)(row0 + ai * HALF + m * 16) * ldc + col0;
#pragma unroll
                for (int bj = 0; bj < 2; ++bj) { const f32x4 v0 = acc[ai][bj][m][0] + bv[bj][0], v1 = acc[ai][bj][m][1] + bv[bj][1];
                    u32x4 w; w.x = cvt_pk_bf16(v0[0], v0[1]); w.y = cvt_pk_bf16(v0[2], v0[3]); w.z = cvt_pk_bf16(v1[0], v1[1]); w.w = cvt_pk_bf16(v1[2], v1[3]);
                    *(u32x4*)(rowp + bj * HALF) = w; } }
    }
};
struct EpiSwiGLU {
    static constexpr bool PERM = true, AFTER_DRAIN = false;
    bf16_t* O; int ldc;
    __device__ __forceinline__ void operator()(const f32x4 (&acc)[2][2][4][2], const Unit& u, int wr, int wc, int fr_, int fq_) const {
        int fr = fr_, fq = fq_; asm volatile("" : "+v"(fr), "+v"(fq));
        const int row0 = u.pm * BM + wr * 64 + fr, col0 = u.pn * HALF + wc * 32 + 8 * fq;
#pragma unroll
        for (int ai = 0; ai < 2; ++ai)
#pragma unroll
            for (int m = 0; m < 4; ++m) { bf16_t* rowp = O + (size_t)(row0 + ai * HALF + m * 16) * ldc + col0;
                float r[8];
#pragma unroll
                for (int n = 0; n < 2; ++n)
#pragma unroll
                    for (int e = 0; e < 4; ++e) { const float a = acc[ai][0][m][n][e], b = acc[ai][1][m][n][e]; r[4 * n + e] = a * sigmoid_fast(a) * b; }
                u32x4 w; w.x = cvt_pk_bf16(r[0], r[1]); w.y = cvt_pk_bf16(r[2], r[3]); w.z = cvt_pk_bf16(r[4], r[5]); w.w = cvt_pk_bf16(r[6], r[7]);
                *(u32x4*)rowp = w; }
    }
};
struct EpiGLU {
    static constexpr bool PERM = true, AFTER_DRAIN = false;
    bf16_t* O; int ldc; const bf16_t* Y; int ldy; const float* bias;
    __device__ __forceinline__ void operator()(const f32x4 (&acc)[2][2][4][2], const Unit& u, int wr, int wc, int fr_, int fq_) const {
        int fr = fr_, fq = fq_; asm volatile("" : "+v"(fr), "+v"(fq));
        const int row0 = u.pm * BM + wr * 64 + fr, col0 = u.pn * BM + wc * 32 + 8 * fq;
        f32x4 bv[2][2];
#pragma unroll
        for (int bj = 0; bj < 2; ++bj)
#pragma unroll
            for (int n = 0; n < 2; ++n) bv[bj][n] = *(const f32x4*)(bias + col0 + bj * HALF + 4 * n);
#pragma unroll
        for (int ai = 0; ai < 2; ++ai)
#pragma unroll
            for (int m = 0; m < 4; ++m) { const size_t r = (size_t)(row0 + ai * HALF + m * 16);
#pragma unroll
                for (int bj = 0; bj < 2; ++bj) { const u32x4 yw = *(const u32x4*)(Y + r * ldy + col0 + bj * HALF);
                    const f32x4 v0 = acc[ai][bj][m][0] + bv[bj][0], v1 = acc[ai][bj][m][1] + bv[bj][1];
                    u32x4 w; w.x = cvt_pk_bf16(bf_lo(yw.x) * sigmoid_fast(v0[0]), bf_hi(yw.x) * sigmoid_fast(v0[1])); w.y = cvt_pk_bf16(bf_lo(yw.y) * sigmoid_fast(v0[2]), bf_hi(yw.y) * sigmoid_fast(v0[3]));
                    w.z = cvt_pk_bf16(bf_lo(yw.z) * sigmoid_fast(v1[0]), bf_hi(yw.z) * sigmoid_fast(v1[1])); w.w = cvt_pk_bf16(bf_lo(yw.w) * sigmoid_fast(v1[2]), bf_hi(yw.w) * sigmoid_fast(v1[3]));
                    *(u32x4*)(O + r * ldc + col0 + bj * HALF) = w; } }
    }
};
struct EpiGate {
    static constexpr bool PERM = true, AFTER_DRAIN = false;
    bf16_t* O; int ldc; const bf16_t* L; int ldl;
    __device__ __forceinline__ void operator()(const f32x4 (&acc)[2][2][4][2], const Unit& u, int wr, int wc, int fr_, int fq_) const {
        int fr = fr_, fq = fq_; asm volatile("" : "+v"(fr), "+v"(fq));
        const int row0 = u.pm * BM + wr * 64 + fr, col0 = u.pn * BM + wc * 32 + 8 * fq;
#pragma unroll
        for (int ai = 0; ai < 2; ++ai)
#pragma unroll
            for (int m = 0; m < 4; ++m) { const size_t r = (size_t)(row0 + ai * HALF + m * 16);
#pragma unroll
                for (int bj = 0; bj < 2; ++bj) { const u32x4 lw = *(const u32x4*)(L + r * ldl + col0 + bj * HALF);
                    const f32x4 v0 = acc[ai][bj][m][0], v1 = acc[ai][bj][m][1];
                    u32x4 w; w.x = cvt_pk_bf16(v0[0] * sigmoid_fast(bf_lo(lw.x)), v0[1] * sigmoid_fast(bf_hi(lw.x))); w.y = cvt_pk_bf16(v0[2] * sigmoid_fast(bf_lo(lw.y)), v0[3] * sigmoid_fast(bf_hi(lw.y)));
                    w.z = cvt_pk_bf16(v1[0] * sigmoid_fast(bf_lo(lw.z)), v1[1] * sigmoid_fast(bf_hi(lw.z))); w.w = cvt_pk_bf16(v1[2] * sigmoid_fast(bf_lo(lw.w)), v1[3] * sigmoid_fast(bf_hi(lw.w)));
                    *(u32x4*)(O + r * ldc + col0 + bj * HALF) = w; } }
    }
};

struct EpiInProj {
    static constexpr bool PERM = true, AFTER_DRAIN = false;
    bf16_t* O; int ldc; const float* bias; bf16_t* U; int UT, NR, KE;
    __device__ __forceinline__ void operator()(const f32x4 (&acc)[2][2][4][2], const Unit& u, int wr, int wc, int fr_, int fq_) const {
        int fr = fr_, fq = fq_; asm volatile("" : "+v"(fr), "+v"(fq));
        const int row0 = u.pm * BM + wr * 64 + fr, col0 = u.pn * BM + wc * 32 + 8 * fq;
        f32x4 bv[2][2];
#pragma unroll
        for (int bj = 0; bj < 2; ++bj)
#pragma unroll
            for (int n = 0; n < 2; ++n) bv[bj][n] = *(const f32x4*)(bias + col0 + bj * HALF + 4 * n);
        const bool is_u = u.pn >= UT;
#pragma unroll
        for (int ai = 0; ai < 2; ++ai)
#pragma unroll
            for (int m = 0; m < 4; ++m) { const int row = row0 + ai * HALF + m * 16;
#pragma unroll
                for (int bj = 0; bj < 2; ++bj) { const f32x4 v0 = acc[ai][bj][m][0] + bv[bj][0], v1 = acc[ai][bj][m][1] + bv[bj][1];
                    u32x4 w; w.x = cvt_pk_bf16(v0[0], v0[1]); w.y = cvt_pk_bf16(v0[2], v0[3]); w.z = cvt_pk_bf16(v1[0], v1[1]); w.w = cvt_pk_bf16(v1[2], v1[3]);
                    if (!is_u) *(u32x4*)(O + (size_t)row * ldc + col0 + bj * HALF) = w;
                    else { const int j = col0 + bj * HALF - UT * BM, g = j >> 4, k0 = j & 15;
                        *(u32x4*)(U + ((size_t)g * NR + (row >> 4)) * KE + (row & 15) * 16 + k0) = w; } } }
    }
};
struct EpiSsmState {
    static constexpr bool PERM = false, AFTER_DRAIN = true;
    bf16_t* U; const float* dec; int KE;
    __device__ __forceinline__ void fused(f32x4 (&acc)[2][2][4][2], const Unit& u, int wr, int wc, int fr, int fq, PG8_LAS unsigned char* lds, int wid, int lane) const {
        typedef float f32x2v __attribute__((ext_vector_type(2)));
        PG8_LAS float* loc = (PG8_LAS float*)lds;
        PG8_LAS f32x2v* Eseg = (PG8_LAS f32x2v*)(lds + STAGE_BYTES + 1024);
#pragma unroll
        for (int ai = 0; ai < 2; ++ai)
#pragma unroll
            for (int m = 0; m < 4; ++m)
#pragma unroll
                for (int n = 0; n < 2; ++n) *(PG8_LAS f32x4*)(loc + (ai * HALF + wr * 64 + m * 16 + fr) * 128 + wc * 32 + n * 16 + fq * 4) = acc[ai][0][m][n];
        asm volatile("s_waitcnt lgkmcnt(0)" ::: "memory"); __builtin_amdgcn_s_barrier(); asm volatile("" ::: "memory");
        const int g = u.pm >> 2, p = lane;
        const float ar = dec[(g * 64 + p) * 2], ai_ = dec[(g * 64 + p) * 2 + 1];
        float xr = 0.f, xi = 0.f;
        for (int i = 0; i < 32; ++i) { const f32x2v l = *(const PG8_LAS f32x2v*)(loc + (wid * 32 + i) * 128 + 2 * p); const float nr = ar * xr - ai_ * xi + l.x, ni = ar * xi + ai_ * xr + l.y; xr = nr; xi = ni; }
        Eseg[wid * 64 + p] = (f32x2v){xr, xi};
        asm volatile("s_waitcnt lgkmcnt(0)" ::: "memory"); __builtin_amdgcn_s_barrier(); asm volatile("" ::: "memory");
        float br = ar, bi = ai_;
#pragma unroll
        for (int s = 0; s < 5; ++s) { const float t = br * br - bi * bi; bi = 2.f * br * bi; br = t; }
        xr = 0.f; xi = 0.f;
        for (int w2 = 0; w2 < wid; ++w2) { const f32x2v e = Eseg[w2 * 64 + p]; const float nr = br * xr - bi * xi + e.x, ni = br * xi + bi * xr + e.y; xr = nr; xi = ni; }
        bf16_t* up = U + ((size_t)u.pm * BM + wid * 32) * KE + 256 + 2 * p;
        for (int i = 0; i < 32; ++i) { *(unsigned*)(up + (size_t)i * KE) = cvt_pk_bf16(xr, xi);
            const f32x2v l = *(const PG8_LAS f32x2v*)(loc + (wid * 32 + i) * 128 + 2 * p); const float nr = ar * xr - ai_ * xi + l.x, ni = ar * xi + ai_ * xr + l.y; xr = nr; xi = ni; }
    }
};
__device__ __forceinline__ float gelu_tanh_f(float x) { const float t = 0.7978845608028654f * (x + 0.044715f * x * x * x); const float e = __builtin_amdgcn_exp2f(2.885390081777927f * t); return x - x * __builtin_amdgcn_rcpf(e + 1.0f); }
struct EpiSsmMain {
    static constexpr bool PERM = true, AFTER_DRAIN = false;
    bf16_t* Y; int ldy; const bf16_t* U; int KE, NR; const float* dsk;
    __device__ __forceinline__ void operator()(const f32x4 (&acc)[2][2][4][2], const Unit& u, int wr, int wc, int fr_, int fq_) const {
        int fr = fr_, fq = fq_; asm volatile("" : "+v"(fr), "+v"(fq));
        const int row0 = u.pm * BM + wr * 64 + fr, col0 = wc * 32 + 8 * fq, g = u.pm >> 2;
        f32x4 dv[2];
        dv[0] = *(const f32x4*)(dsk + g * 16 + (col0 & 15)); dv[1] = *(const f32x4*)(dsk + g * 16 + (col0 & 15) + 4);
        const bf16_t* Ub = U + (size_t)row0 * KE + col0;
        bf16_t* Yb = Y + ((size_t)(row0 - g * NR) * 16 + (col0 >> 4)) * ldy + g * 16 + (col0 & 15);
#pragma unroll
        for (int ai = 0; ai < 2; ++ai)
#pragma unroll
            for (int m = 0; m < 4; ++m) {
#pragma unroll
                for (int bj = 0; bj < 2; ++bj) {
                    const u32x4 uw = *(const u32x4*)(Ub + (size_t)(ai * HALF + m * 16) * KE + bj * HALF);
                    const f32x4 a0 = acc[ai][bj][m][0], a1 = acc[ai][bj][m][1];
                    u32x4 w;
                    w.x = cvt_pk_bf16(gelu_tanh_f(a0[0] + dv[0][0] * bf_lo(uw.x)), gelu_tanh_f(a0[1] + dv[0][1] * bf_hi(uw.x)));
                    w.y = cvt_pk_bf16(gelu_tanh_f(a0[2] + dv[0][2] * bf_lo(uw.y)), gelu_tanh_f(a0[3] + dv[0][3] * bf_hi(uw.y)));
                    w.z = cvt_pk_bf16(gelu_tanh_f(a1[0] + dv[1][0] * bf_lo(uw.z)), gelu_tanh_f(a1[1] + dv[1][1] * bf_hi(uw.z)));
                    w.w = cvt_pk_bf16(gelu_tanh_f(a1[2] + dv[1][2] * bf_lo(uw.w)), gelu_tanh_f(a1[3] + dv[1][3] * bf_hi(uw.w)));
                    *(u32x4*)(Yb + ((size_t)(ai * HALF + m * 16) * 16 + 8 * bj) * ldy) = w;
                    asm volatile("" ::: "memory"); } }
    }
};

struct BranchOrder {
    StaticOrder so;
    __host__ __device__ void init(int M, int G_, int c_) { so.init(M, 1024, G_, c_); }
    __host__ __device__ bool next(int i, Unit& u) const { const int r = i / 3, br = i - 3 * r; if (!so.next(r, u)) return false; u.pn += 4 * br; return true; }
    __device__ __forceinline__ void a_ready(const Unit&) const {}
    __device__ __forceinline__ void done(const Unit&) const {}
};
struct EpiGateAcc {
    static constexpr bool PERM = true, AFTER_DRAIN = false;
    float* Mb; bf16_t* O; int ldc; const bf16_t* L; int ldl;
    __device__ __forceinline__ void operator()(const f32x4 (&acc)[2][2][4][2], const Unit& u, int wr, int wc, int fr_, int fq_) const {
        int fr = fr_, fq = fq_; asm volatile("" : "+v"(fr), "+v"(fq));
        const int br = u.pn >> 2, row0 = u.pm * BM + wr * 64 + fr, col0 = (u.pn & 3) * BM + wc * 32 + 8 * fq;
        const bf16_t* Lb = L + (size_t)row0 * ldl + br * 1024 + col0; float* Mp = Mb + (size_t)row0 * ldc + col0; bf16_t* Ob = O + (size_t)row0 * ldc + col0;
#pragma unroll
        for (int ai = 0; ai < 2; ++ai)
#pragma unroll
            for (int m = 0; m < 4; ++m) { const size_t ro = (size_t)(ai * HALF + m * 16);
#pragma unroll
                for (int bj = 0; bj < 2; ++bj) { const u32x4 lw = *(const u32x4*)(Lb + ro * ldl + bj * HALF);
                    f32x4 v0 = acc[ai][bj][m][0], v1 = acc[ai][bj][m][1];
                    v0[0] *= sigmoid_fast(bf_lo(lw.x)); v0[1] *= sigmoid_fast(bf_hi(lw.x)); v0[2] *= sigmoid_fast(bf_lo(lw.y)); v0[3] *= sigmoid_fast(bf_hi(lw.y));
                    v1[0] *= sigmoid_fast(bf_lo(lw.z)); v1[1] *= sigmoid_fast(bf_hi(lw.z)); v1[2] *= sigmoid_fast(bf_lo(lw.w)); v1[3] *= sigmoid_fast(bf_hi(lw.w));
                    float* mp = Mp + ro * ldc + bj * HALF;
                    if (br > 0) { v0 += *(const f32x4*)mp; v1 += *(const f32x4*)(mp + 4); }
                    if (br < 2) { *(f32x4*)mp = v0; *(f32x4*)(mp + 4) = v1; }
                    else { u32x4 w; w.x = cvt_pk_bf16(v0[0], v0[1]); w.y = cvt_pk_bf16(v0[2], v0[3]); w.z = cvt_pk_bf16(v1[0], v1[1]); w.w = cvt_pk_bf16(v1[2], v1[3]);
                        *(u32x4*)(Ob + ro * ldc + bj * HALF) = w; } }
                asm volatile("" ::: "memory"); }
    }
};
}
#define GAS __attribute__((address_space(1)))
#define LAS __attribute__((address_space(3)))
typedef unsigned short bf16;
typedef unsigned v4u __attribute__((ext_vector_type(4)));
typedef float f32x4 __attribute__((ext_vector_type(4)));
typedef short bf16x8 __attribute__((ext_vector_type(8)));
typedef GAS unsigned gu32;
typedef GAS unsigned long long gu64;
#define RLX_AGENT __ATOMIC_RELAXED, __HIP_MEMORY_SCOPE_AGENT
#define LDS_WAIT() asm volatile("s_waitcnt lgkmcnt(0)" ::: "memory")
#define VM_WAIT() asm volatile("s_waitcnt vmcnt(0)" ::: "memory")
__device__ __forceinline__ unsigned long long rt() { return __builtin_amdgcn_s_memrealtime(); }
__device__ __forceinline__ unsigned f2bf(float f) { unsigned u = __builtin_bit_cast(unsigned, f); return (u + 0x7fffu + ((u >> 16) & 1u)) >> 16; }
__device__ __forceinline__ unsigned pk2(float lo, float hi) { return f2bf(lo) | (f2bf(hi) << 16); }

#define XB_TMO      128
#define XB_XCNT(j)  (256  + 64 * (j))
#define XB_XSUB(j)  (1280 + 64 * (j))
#define XB_XGEN(j)  (2304 + 64 * (j))
#define XB_TOP      3328
#define XB_TOPGEN   3392
#define XCD_BAR_WORDS 3456
#define XB_SPIN_CAP (1u << 22)

__device__ __forceinline__ unsigned xb_ld(unsigned* p)              { return __hip_atomic_load(p, __ATOMIC_RELAXED, __HIP_MEMORY_SCOPE_AGENT); }
__device__ __forceinline__ unsigned xb_add(unsigned* p, unsigned v) { return __hip_atomic_fetch_add(p, v, __ATOMIC_RELAXED, __HIP_MEMORY_SCOPE_AGENT); }
__device__ __forceinline__ unsigned xb_xcc_id() { return (unsigned)__builtin_amdgcn_s_getreg((3 << 11) | 20) & 0xFu; }
#define XB_SPIN(cond, bar) do { unsigned _sp = 0; while (cond) { __builtin_amdgcn_s_sleep(1); \
    if ((++_sp & 255u) == 0u) { if (xb_ld(&(bar)[XB_TMO])) break; if (_sp > XB_SPIN_CAP) { atomicAdd(&(bar)[XB_TMO], 1u); break; } } } } while (0)

struct XcdBarrier {
    unsigned* bar; unsigned x;
    volatile LAS unsigned* st;
};

__device__ __forceinline__ XcdBarrier xcd_barrier_post(unsigned* bar, volatile LAS unsigned* st) {
    XcdBarrier b; b.bar = bar; b.x = xb_xcc_id(); b.st = st;
    if (threadIdx.x == 0) (void)xb_add(&bar[XB_XCNT(b.x)], 1u);
    return b;
}
__device__ __forceinline__ void xcd_barrier_complete(unsigned* bar, unsigned x, unsigned& nloc, unsigned& nx) {
    const unsigned G = gridDim.x * gridDim.y * gridDim.z;
    unsigned sum, cnt, mine, sp = 0u;
    for (;;) {
        sum = 0u; cnt = 0u; mine = 0u;
#pragma unroll
        for (unsigned j = 0; j < 16; ++j) { const unsigned c = xb_ld(&bar[XB_XCNT(j)]); sum += c; cnt += (c > 0u) ? 1u : 0u; mine = (j == x) ? c : mine; }
        if (sum == G) break;
        __builtin_amdgcn_s_sleep(1);
        if ((++sp & 255u) == 0u) { if (xb_ld(&bar[XB_TMO])) break; if (sp > XB_SPIN_CAP) { atomicAdd(&bar[XB_TMO], 1u); break; } }
    }
    nloc = mine > 0u ? mine : 1u; nx = cnt > 0u ? cnt : 1u;
}

__device__ __forceinline__ void xcd_barrier(const XcdBarrier& b, int tid_) {
    asm volatile("s_waitcnt vmcnt(0)" ::: "memory");
    __syncthreads();
    if (tid_ == 0) {
        unsigned* bar = b.bar;
        __builtin_amdgcn_s_waitcnt(0);
        unsigned nloc = b.st[0], nx = b.st[1];
        if (nloc == 0u) { xcd_barrier_complete(bar, b.x, nloc, nx); b.st[0] = nloc; b.st[1] = nx; }
        const unsigned old = xb_add(&bar[XB_XSUB(b.x)], 1u);
        const unsigned gen = old / nloc;
        if (old + 1u == (gen + 1u) * nloc) {
            __builtin_amdgcn_fence(__ATOMIC_RELEASE, "agent");
            asm volatile("s_waitcnt vmcnt(0)" ::: "memory");
            const unsigned og = xb_add(&bar[XB_TOP], 1u);
            const unsigned tg = og / nx;
            if (og + 1u == (tg + 1u) * nx) xb_add(&bar[XB_TOPGEN], 1u);
            else XB_SPIN(xb_ld(&bar[XB_TOPGEN]) == tg, bar);
            __builtin_amdgcn_fence(__ATOMIC_ACQUIRE, "agent");
            xb_add(&bar[XB_XGEN(b.x)], 1u);
            asm volatile("s_waitcnt vmcnt(0)" ::: "memory");
        } else {
            XB_SPIN(xb_ld(&bar[XB_XGEN(b.x)]) == gen, bar);
            __builtin_amdgcn_fence(__ATOMIC_ACQUIRE, "agent");
            asm volatile("s_waitcnt vmcnt(0)" ::: "memory");
        }
    }
    __syncthreads();
}

constexpr int NWAVES = 8;
constexpr int DM = 1024, NBATCH = 16, SEQ = 4096, DEPTH = 4, DFF = 2816, MALL = NBATCH * SEQ;
constexpr int NIN = 8864, NINP = 8960;
constexpr int C_QA = 0, C_KVA = 384, C_KR = 640, C_DIL = 672, C_GATE = 5280, C_PAD = 8352, C_U = 8448;
constexpr int SRC_U = 5280, SRC_GATE = 5792;
constexpr int QR = 384, KVR = 256;
constexpr int CHB = 4, CHROWS = CHB * SEQ, NCHUNK = NBATCH / CHB;
constexpr float LN_EPS = 1e-5f, RMS_EPS = 1e-6f;
constexpr float DN_ALPHA = 1.681792830507429f;
constexpr float LOG2E = 1.4426950408889634f;

constexpr size_t MiB = 1u << 20;
constexpr size_t WS_CTL = 0, CTL_ZERO_BYTES = 1 * MiB;
constexpr size_t WS_ADA = 1 * MiB;
constexpr size_t WS_SMALL = 4 * MiB;
constexpr size_t SM_BIAS = 0, SM_PW = 64 * 1024, SM_BRE = 384 * 1024, SM_BIM = 512 * 1024, SM_CRE = 640 * 1024, SM_CIM = 768 * 1024, SM_DEC = 896 * 1024;
constexpr int SSM_T = 16, SSM_NR = 1024  , SSM_KE = 384  ;
constexpr size_t WS_ROPE = 6 * MiB;
constexpr size_t WS_W = 14 * MiB;
constexpr size_t W_13 = 0, W_13_SZ = (size_t)2 * DFF * DM * 2;
constexpr size_t W_2 = W_13 + 2 * W_13_SZ, W_2_SZ = (size_t)DM * DFF * 2;
constexpr size_t W_IN = W_2 + 2 * W_2_SZ, W_IN_SZ = (size_t)NINP * DM * 2;
constexpr size_t W_QB = W_IN + W_IN_SZ, W_QB_SZ = (size_t)768 * QR * 2;
constexpr size_t W_KVB = W_QB + W_QB_SZ, W_KVB_SZ = (size_t)1024 * KVR * 2;
constexpr size_t W_GLU = W_KVB + W_KVB_SZ, W_GLU_SZ = (size_t)512 * 512 * 2;
constexpr size_t W_BR = W_GLU + W_GLU_SZ, W_BR_SZ = (size_t)3072 * 512 * 2;
constexpr size_t W_OUT = W_BR + W_BR_SZ, W_OUT_SZ = (size_t)1024 * 3072 * 2;
constexpr size_t W_SM = W_OUT + W_OUT_SZ, W_SM_SZ = (size_t)32 * 256 * SSM_KE * 2;
constexpr size_t W_SS = W_SM + W_SM_SZ, W_SS_SZ = (size_t)32 * 256 * 256 * 2;
constexpr size_t W_END = W_SS + W_SS_SZ;
static_assert(W_END <= 80 * MiB, "weights region");
constexpr size_t WS_HM = 94 * MiB;
constexpr size_t WS_H16 = 222 * MiB;
constexpr size_t WS_BIG = 350 * MiB;
constexpr size_t WS_G = WS_BIG;
constexpr size_t WS_F_FFN = WS_BIG + 352 * MiB;
constexpr size_t WS_F_MIX = WS_BIG;
constexpr size_t WS_PROJ = WS_BIG;
constexpr size_t WS_QRAW = WS_BIG + 280 * MiB;
constexpr size_t WS_KVRAW = WS_QRAW + 24 * MiB;
constexpr size_t WS_QF = WS_KVRAW + 32 * MiB;
constexpr size_t WS_KF = WS_QF + 24 * MiB;
constexpr size_t WS_VF = WS_KF + 24 * MiB;
constexpr size_t WS_YS = WS_VF + 16 * MiB;
constexpr size_t WS_Y3 = WS_YS + 16 * MiB;
constexpr size_t WS_OG = WS_Y3 + 48 * MiB;
constexpr size_t WS_LSE = WS_OG + 48 * MiB;
constexpr size_t WS_T = WS_LSE + 1 * MiB;
constexpr size_t WS_UG = WS_T + 96 * MiB;
constexpr size_t WS_END = WS_UG + 24 * MiB;
static_assert(WS_END <= 1024 * MiB && WS_F_FFN + (size_t)MALL * DM * 2 <= 1024 * MiB && WS_H16 + (size_t)MALL * DM * 2 <= WS_BIG, "d_ws map");
constexpr int CW_BAR = 4096;

constexpr int RING_OFF = 0, RING_BYTES = 131072;
constexpr int LDSCTL_OFF = RING_BYTES, MISC_OFF = LDSCTL_OFF + 320;
constexpr int LDS_BYTES = 147456;

typedef unsigned v2u __attribute__((ext_vector_type(2)));
struct Frame {
    LAS unsigned char* lds;
    int tid, lane, wave, G, bid;
};
struct Args { const void* in[28]; float* out; unsigned char* ws; int ph_lo, ph_hi; };

__device__ __forceinline__ float lane_xor(float v, int o, int lane) { return __builtin_bit_cast(float, __builtin_amdgcn_ds_bpermute((lane ^ o) << 2, __builtin_bit_cast(int, v))); }
__device__ __forceinline__ float lane_get(float v, int src) { return __builtin_bit_cast(float, __builtin_amdgcn_ds_bpermute(src << 2, __builtin_bit_cast(int, v))); }
__device__ __forceinline__ float wave_sum(float v, int lane) {
#pragma unroll
    for (int o = 1; o < 64; o <<= 1) v += lane_xor(v, o, lane);
    return v;
}
__device__ __forceinline__ float bf2f(unsigned short h) { return __builtin_bit_cast(float, (unsigned)h << 16); }
__device__ __forceinline__ float bflo(unsigned w) { return __builtin_bit_cast(float, w << 16); }
__device__ __forceinline__ float bfhi(unsigned w) { return __builtin_bit_cast(float, w & 0xffff0000u); }

__device__ __forceinline__ void phase_ada(Frame& F, const float* cvec, const float* w_ada, const float* b_ada, float* ada) {
    LAS float* cond = (LAS float*)(F.lds);
    LAS float* red = (LAS float*)(F.lds + 65536);
    for (int u = F.bid; u < DEPTH * 64; u += F.G) {
        const int l = u >> 6, n0 = (u & 63) * 144;
        for (int i = F.tid; i < NBATCH * DM; i += NWAVES * 64) { const float c = cvec[i]; cond[(i & 1023) * 16 + (i >> 10)] = c / (1.0f + __expf(-c)); }
        __syncthreads();
        const int ks = F.tid / 36, q = F.tid - ks * 36;
        float acc[16][4];
#pragma unroll
        for (int b = 0; b < 16; ++b) { acc[b][0] = 0.f; acc[b][1] = 0.f; acc[b][2] = 0.f; acc[b][3] = 0.f; }
        if (ks < 14) {
            const int k0 = (ks * 1024) / 14, k1 = ((ks + 1) * 1024) / 14;
            const float* wp = w_ada + ((size_t)l * DM) * 9216 + n0 + 4 * q;
#pragma unroll 8
            for (int k = k0; k < k1; ++k) { const f32x4 w = *(const f32x4*)(wp + (size_t)k * 9216);
#pragma unroll
                for (int b4 = 0; b4 < 4; ++b4) { const f32x4 c = *(const LAS f32x4*)(cond + k * 16 + 4 * b4);
                    acc[4 * b4 + 0][0] += c.x * w.x; acc[4 * b4 + 0][1] += c.x * w.y; acc[4 * b4 + 0][2] += c.x * w.z; acc[4 * b4 + 0][3] += c.x * w.w;
                    acc[4 * b4 + 1][0] += c.y * w.x; acc[4 * b4 + 1][1] += c.y * w.y; acc[4 * b4 + 1][2] += c.y * w.z; acc[4 * b4 + 1][3] += c.y * w.w;
                    acc[4 * b4 + 2][0] += c.z * w.x; acc[4 * b4 + 2][1] += c.z * w.y; acc[4 * b4 + 2][2] += c.z * w.z; acc[4 * b4 + 2][3] += c.z * w.w;
                    acc[4 * b4 + 3][0] += c.w * w.x; acc[4 * b4 + 3][1] += c.w * w.y; acc[4 * b4 + 3][2] += c.w * w.z; acc[4 * b4 + 3][3] += c.w * w.w; } }
        }
        float ps[5];
#pragma unroll
        for (int r = 0; r < 2; ++r) {
            if (ks < 14 && ks / 7 == r) { const int kr = ks - 7 * r;
#pragma unroll
                for (int b = 0; b < 16; ++b) *(LAS f32x4*)(red + (kr * 16 + b) * 144 + 4 * q) = (f32x4){acc[b][0], acc[b][1], acc[b][2], acc[b][3]}; }
            __syncthreads();
#pragma unroll
            for (int i = 0; i < 5; ++i) { const int idx = F.tid + 512 * i;
                if (idx < 2304) { float sm = (r == 0) ? 0.f : ps[i];
#pragma unroll
                    for (int kr = 0; kr < 7; ++kr) sm += red[kr * 2304 + idx];
                    ps[i] = sm; } }
            __syncthreads();
        }
#pragma unroll
        for (int i = 0; i < 5; ++i) { const int idx = F.tid + 512 * i;
            if (idx < 2304) { const int b = idx / 144, n = idx - b * 144; ada[((size_t)l * 16 + b) * 9216 + n0 + n] = ps[i] + b_ada[(size_t)l * 9216 + n0 + n]; } }
    }
}

__device__ __forceinline__ void conv_item(const float* W, int N, bf16* dst, int pitch, int koff, int mode, int hi, const float* kscale, LAS float* scr, int item, int lane, int ncopy) {
    const int nblk = N / 32, kb = item / nblk, nb = item % nblk, k0 = 64 * kb, n0 = 32 * nb;
#pragma unroll 8
    for (int i = 0; i < 32; ++i) { const int kk = 2 * i + (lane >> 5); float v = W[(size_t)(k0 + kk) * N + n0 + (lane & 31)]; if (kscale) v *= kscale[k0 + kk]; scr[kk * 33 + (lane & 31)] = v; }
    LDS_WAIT(); asm volatile("" ::: "memory");
    const int c = lane & 7;
    const int r0 = (mode == 0) ? n0 : (mode == 1) ? ((n0 >> 7) * 256 + (n0 & 127) + (hi ? 128 : 0)) : (n0 < SRC_U ? n0 : (n0 < SRC_GATE ? n0 - SRC_U + C_U : n0 - (SRC_GATE - C_GATE)));
#pragma unroll
    for (int j = 0; j < 4; ++j) { const int n = (lane >> 3) + 8 * j; const LAS float* s = scr + (8 * c) * 33 + n;
        v4u o; o.x = pk2(s[0 * 33], s[1 * 33]); o.y = pk2(s[2 * 33], s[3 * 33]); o.z = pk2(s[4 * 33], s[5 * 33]); o.w = pk2(s[6 * 33], s[7 * 33]);
        for (int cp = 0; cp < ncopy; ++cp) *(GAS v4u*)(dst + (size_t)(r0 + n) * pitch + koff + cp * 1024 + k0 + 8 * c) = o; }
    LDS_WAIT(); asm volatile("" ::: "memory");
}
__device__ __forceinline__ void conv_job(Frame& F, const float* W, int K, int N, bf16* dst, int pitch, int mode, int hi, const float* kscale, int ncopy) {
    LAS float* scr = (LAS float*)(F.lds + RING_OFF + F.wave * 16384);
    const int gw = F.bid * NWAVES + F.wave, NGW = F.G * NWAVES, nitems = (K / 64) * (N / 32);
    for (int it = gw; it < nitems; it += NGW) conv_item(W, N, dst, pitch, 0, mode, hi, kscale, scr, it, F.lane, ncopy);
}
struct ConvJob { const float* src; const float* ksc; bf16* dst; int N, pitch, mode, hi, loc; };
__device__ __forceinline__ void conv_load(const ConvJob& J, int lane, f32x4 (&r)[8]) {
    const int nblk = J.N / 32, kb = J.loc / nblk, nb = J.loc - kb * nblk, k0 = 64 * kb, n0 = 32 * nb;
    const float* p = J.src + (size_t)(k0 + (lane >> 3)) * J.N + n0 + 4 * (lane & 7);
#pragma unroll
    for (int i = 0; i < 8; ++i) r[i] = *(const f32x4*)(p + (size_t)(8 * i) * J.N);
}
__device__ __forceinline__ void conv_store(const ConvJob& J, LAS float* scr, int lane, f32x4 (&r)[8]) {
    const int nblk = J.N / 32, kb = J.loc / nblk, nb = J.loc - kb * nblk, k0 = 64 * kb, n0 = 32 * nb;
    if (J.ksc) {
#pragma unroll
        for (int i = 0; i < 8; ++i) { const float sc = J.ksc[k0 + 8 * i + (lane >> 3)]; r[i] *= sc; } }
#pragma unroll
    for (int i = 0; i < 8; ++i) { LAS float* d = scr + (8 * i + (lane >> 3)) * 33 + 4 * (lane & 7); d[0] = r[i].x; d[1] = r[i].y; d[2] = r[i].z; d[3] = r[i].w; }
    LDS_WAIT(); asm volatile("" ::: "memory");
    const int c = lane & 7, mode = J.mode;
    const int r0 = (mode == 0) ? n0 : (mode == 1) ? ((n0 >> 7) * 256 + (n0 & 127) + (J.hi ? 128 : 0)) : (n0 < SRC_U ? n0 : (n0 < SRC_GATE ? n0 - SRC_U + C_U : n0 - (SRC_GATE - C_GATE)));
#pragma unroll
    for (int j = 0; j < 4; ++j) { const int n = (lane >> 3) + 8 * j; const LAS float* sp = scr + (8 * c) * 33 + n;
        v4u o; o.x = pk2(sp[0 * 33], sp[1 * 33]); o.y = pk2(sp[2 * 33], sp[3 * 33]); o.z = pk2(sp[4 * 33], sp[5 * 33]); o.w = pk2(sp[6 * 33], sp[7 * 33]);
        *(GAS v4u*)(J.dst + (size_t)(r0 + n) * J.pitch + k0 + 8 * c) = o; }
    LDS_WAIT(); asm volatile("" ::: "memory");
}
__device__ __forceinline__ ConvJob conv_decode(const Args& A, int l, unsigned char* wbase, int it) {
    int j, loc;
    if (it < 8448) { j = it / 1408; loc = it - j * 1408; }
    else if (it < 12880) { j = 6; loc = it - 8448; }
    else if (it < 13024) { j = 7; loc = it - 12880; }
    else if (it < 13152) { j = 8; loc = it - 13024; }
    else if (it < 13280) { j = 9; loc = it - 13152; }
    else if (it < 14048) { const int q = (it - 13280) >> 8; j = 10 + q; loc = (it - 13280) & 255; }
    else { j = 13; loc = it - 14048; }
    const float* src; int N, pitch, mode = 0, hi = 0; size_t dsto; const float* ksc = nullptr;
    if (j < 6) { const int s = j / 3, t = j - 3 * s; const size_t o13 = ((size_t)l * 2 + s) * DM * DFF;
        if (t == 0) { src = (const float*)A.in[7] + o13; N = DFF; pitch = DM; mode = 1; hi = 0; dsto = W_13 + s * W_13_SZ; }
        else if (t == 1) { src = (const float*)A.in[8] + o13; N = DFF; pitch = DM; mode = 1; hi = 1; dsto = W_13 + s * W_13_SZ; }
        else { src = (const float*)A.in[9] + o13; N = DM; pitch = DFF; dsto = W_2 + s * W_2_SZ; } }
    else if (j == 6) { src = (const float*)A.in[10] + (size_t)l * DM * NIN; N = NIN; pitch = DM; dsto = W_IN; mode = 2; }
    else if (j == 7) { src = (const float*)A.in[14] + (size_t)l * QR * 768; N = 768; pitch = QR; dsto = W_QB; ksc = (const float*)A.in[12] + l * QR; }
    else if (j == 8) { src = (const float*)A.in[15] + (size_t)l * KVR * 1024; N = 1024; pitch = KVR; dsto = W_KVB; ksc = (const float*)A.in[13] + l * KVR; }
    else if (j == 9) { src = (const float*)A.in[24] + (size_t)l * 512 * 512; N = 512; pitch = 512; dsto = W_GLU; }
    else if (j < 13) { const int i = j - 10; src = (const float*)A.in[26] + ((size_t)l * 3 + i) * 512 * 1024; N = 1024; pitch = 512; dsto = W_BR + (size_t)i * 1024 * 512 * 2; }
    else { src = (const float*)A.in[27] + (size_t)l * DM * DM; N = DM; pitch = DM; dsto = W_OUT; }
    ConvJob J; J.src = src; J.ksc = ksc; J.dst = (bf16*)(wbase + dsto); J.N = N; J.pitch = pitch; J.mode = mode; J.hi = hi; J.loc = loc;
    return J;
}
__device__ __forceinline__ void phase_wconv(Frame& F, const Args& A, int l) {
    unsigned char* ws = A.ws; bf16* wb = (bf16*)(ws + WS_W);
    {
        LAS float* scr = (LAS float*)(F.lds + RING_OFF + F.wave * 16384);
        const int gw = F.bid * NWAVES + F.wave, NGW = F.G * NWAVES;
        int it = gw;
        if (it < 14560) {
            ConvJob J = conv_decode(A, l, (unsigned char*)wb, it); f32x4 r[8]; conv_load(J, F.lane, r);
#pragma nounroll
            while (true) {
                const int itn = it + NGW; const bool more = itn < 14560;
                ConvJob Jn; f32x4 rn[8];
                if (more) { Jn = conv_decode(A, l, (unsigned char*)wb, itn); conv_load(Jn, F.lane, rn); }
                conv_store(J, scr, F.lane, r);
                if (!more) break;
                J = Jn; it = itn;
#pragma unroll
                for (int i = 0; i < 8; ++i) r[i] = rn[i];
            }
        }
    }
    const int gt = F.bid * (NWAVES * 64) + F.tid, NT = F.G * NWAVES * 64;
    { GAS v4u* z = (GAS v4u*)((unsigned char*)wb + W_IN + (size_t)C_PAD * DM * 2); const int nz = (C_U - C_PAD) * DM * 2 / 16;
      unsigned zz = 0u; asm volatile("" : "+v"(zz));
      for (int i = gt; i < nz; i += NT) z[i] = (v4u){zz, zz, zz, zz}; }
    { float* bp = (float*)(ws + WS_SMALL + SM_BIAS); const float* bin = (const float*)A.in[11] + (size_t)l * NIN;
      for (int i = gt; i < NINP; i += NT) bp[i] = (i < C_GATE) ? bin[i] : (i < C_PAD) ? bin[i + (SRC_GATE - C_GATE)] : (i < C_U) ? 0.f : bin[SRC_U + i - C_U]; }
    { const float* lre = (const float*)A.in[16] + l * 2048; const float* lim = (const float*)A.in[17] + l * 2048; const float* ldt = (const float*)A.in[18] + l * 32;
      const float* bre = (const float*)A.in[19] + (size_t)l * 32768; const float* bim = (const float*)A.in[20] + (size_t)l * 32768;
      const float* cre = (const float*)A.in[21] + (size_t)l * 32768; const float* cim = (const float*)A.in[22] + (size_t)l * 32768;
      float* tpw = (float*)(ws + WS_SMALL + SM_PW); float* tbr = (float*)(ws + WS_SMALL + SM_BRE); float* tbi = (float*)(ws + WS_SMALL + SM_BIM);
      float* tcr = (float*)(ws + WS_SMALL + SM_CRE); float* tci = (float*)(ws + WS_SMALL + SM_CIM); float* tdec = (float*)(ws + WS_SMALL + SM_DEC);
      for (int it = gt; it < 2048 * 17; it += NT) { const int i = it / 17, d = it - 17 * i, g = i >> 6;
          const float dt = expf(ldt[g]), zr = lre[i] * dt, zi = lim[i] * dt;
          const float mg = expf(zr * (float)d), an = zi * (float)d; tpw[(size_t)it * 2] = mg * cosf(an); tpw[(size_t)it * 2 + 1] = mg * sinf(an);
          if (d == 16) { tdec[2 * i] = expf(zr * 16.f) * cosf(zi * 16.f); tdec[2 * i + 1] = expf(zr * 16.f) * sinf(zi * 16.f); } }
      for (int it = gt; it < 32768; it += NT) { const int i = it >> 4, h = it & 15, g = i >> 6, p = i & 63;
          const float dt = expf(ldt[g]), lr = lre[i], li = lim[i], zr = lr * dt, zi = li * dt;
          const float e = expf(zr), cz = cosf(zi), sz = sinf(zi), sh = sinf(0.5f * zi);
          const float nr = expm1f(zr) * cz - 2.0f * sh * sh, ni = e * sz;
          const float den = 1.0f / (lr * lr + li * li), qr = (nr * lr + ni * li) * den, qi = (ni * lr - nr * li) * den;
          const float br = bre[it], bi = bim[it];
          tbr[it] = qr * br - qi * bi; tbi[it] = qr * bi + qi * br;
          tcr[it] = cre[((size_t)g * 16 + h) * 64 + p]; tci[it] = cim[((size_t)g * 16 + h) * 64 + p];
      } }
}
__device__ __forceinline__ void phase_ssm_weights(Frame& F, unsigned char* ws) {
    const float* tpw = (const float*)(ws + WS_SMALL + SM_PW); const float* tbr = (const float*)(ws + WS_SMALL + SM_BRE); const float* tbi = (const float*)(ws + WS_SMALL + SM_BIM);
    const float* tcr = (const float*)(ws + WS_SMALL + SM_CRE); const float* tci = (const float*)(ws + WS_SMALL + SM_CIM);
    bf16* Wm = (bf16*)(ws + WS_W + W_SM); bf16* Wsb = (bf16*)(ws + WS_W + W_SS);
    const int gt = F.bid * (NWAVES * 64) + F.tid, NT = F.G * NWAVES * 64;
    for (int idx = gt; idx < 32 * 16 * 16 * 16; idx += NT) { const int g = idx >> 12, d = (idx >> 8) & 15, k = (idx >> 4) & 15, h = idx & 15;
        float acc = 0.f;
        for (int p = 0; p < 64; ++p) { const size_t i = (size_t)g * 64 + p; const float pr = tpw[(i * 17 + d) * 2], pi = tpw[(i * 17 + d) * 2 + 1], br = tbr[i * 16 + h], bi = tbi[i * 16 + h], cr = tcr[i * 16 + k], ci = tci[i * 16 + k];
            const float wr = pr * br - pi * bi, wi = pr * bi + pi * br; acc += cr * wr - ci * wi; }
        const bf16 v = (bf16)f2bf(acc);
        for (int t = d; t < 16; ++t) Wm[((size_t)g * 256 + t * 16 + k) * SSM_KE + (t - d) * 16 + h] = v;
        if (d >= 1) for (int t = 0; t + d < 16; ++t) Wm[((size_t)g * 256 + t * 16 + k) * SSM_KE + (t + d) * 16 + h] = (bf16)0; }
    for (int idx = gt; idx < 32 * 16 * 16 * 64; idx += NT) { const int g = idx >> 14, t = (idx >> 10) & 15, k = (idx >> 6) & 15, p = idx & 63; const size_t i = (size_t)g * 64 + p;
        const float pr = tpw[(i * 17 + t + 1) * 2], pi = tpw[(i * 17 + t + 1) * 2 + 1], cr = tcr[i * 16 + k], ci = tci[i * 16 + k];
        *(GAS unsigned*)(Wm + ((size_t)g * 256 + t * 16 + k) * SSM_KE + 256 + 2 * p) = pk2(cr * pr - ci * pi, -(cr * pi + ci * pr)); }
    for (int idx = gt; idx < 32 * 64 * 16 * 16; idx += NT) { const int g = idx >> 14, p = (idx >> 8) & 63, s = (idx >> 4) & 15, h = idx & 15; const size_t i = (size_t)g * 64 + p;
        const float pr = tpw[(i * 17 + 15 - s) * 2], pi = tpw[(i * 17 + 15 - s) * 2 + 1], br = tbr[i * 16 + h], bi = tbi[i * 16 + h];
        Wsb[((size_t)g * 256 + 2 * p) * 256 + s * 16 + h] = (bf16)f2bf(pr * br - pi * bi); Wsb[((size_t)g * 256 + 2 * p + 1) * 256 + s * 16 + h] = (bf16)f2bf(pr * bi + pi * br); }
    { unsigned zz = 0u; asm volatile("" : "+v"(zz));
      for (int idx = gt; idx < 32 * 128 * 256 / 8; idx += NT) { const int g = idx >> 12, r = idx & 4095;
          *(GAS v4u*)(Wsb + ((size_t)g * 256 + 128) * 256 + (size_t)r * 8) = (v4u){zz, zz, zz, zz}; } }
}

typedef _Float16 h16x4 __attribute__((ext_vector_type(4)));
__device__ __forceinline__ void phase_lnmod(Frame& F, bool do_ln, const float* hin32, const _Float16* hin16, const bf16* Fs, float* hout32, _Float16* hout16, bf16* hm, int row0, int nrows,
                                            const float* ada_gate  , float rw, const float* lng, const float* lnb, const float* ada_next  ) {
    const int gw = F.bid * NWAVES + F.wave, NGW = F.G * NWAVES, rpw = nrows / NGW;
    const int r_begin = row0 + gw * rpw, b = r_begin / SEQ, lane = F.lane;
    f32x4 ga[4], lg[4], lb[4], sc[4], sh[4];
#pragma unroll
    for (int j = 0; j < 4; ++j) { const int c = 4 * lane + 256 * j;
        if (do_ln) { ga[j] = *(const f32x4*)(ada_gate + (size_t)b * 9216 + c) * rw; lg[j] = *(const f32x4*)(lng + c); lb[j] = *(const f32x4*)(lnb + c); }
        else { ga[j] = (f32x4){0.f, 0.f, 0.f, 0.f}; lg[j] = ga[j]; lb[j] = ga[j]; }
        if (hm) { sh[j] = *(const f32x4*)(ada_next + (size_t)b * 9216 + c); sc[j] = *(const f32x4*)(ada_next + (size_t)b * 9216 + 1024 + c) + 1.0f; }
        else { sh[j] = (f32x4){0.f, 0.f, 0.f, 0.f}; sc[j] = sh[j]; } }
    f32x4 nv32[4]; h16x4 nv16[4]; v2u nfw[4];
#define LN_LOAD(rr) do { const size_t row_ = (size_t)(r_begin + (rr)); \
        if (hin32) { _Pragma("unroll") for (int j = 0; j < 4; ++j) nv32[j] = *(const GAS f32x4*)(hin32 + row_ * DM + 4 * lane + 256 * j); } \
        else { _Pragma("unroll") for (int j = 0; j < 4; ++j) nv16[j] = *(const GAS h16x4*)(hin16 + row_ * DM + 4 * lane + 256 * j); } \
        if (do_ln) { _Pragma("unroll") for (int j = 0; j < 4; ++j) nfw[j] = *(const GAS v2u*)(Fs + (row_ - row0) * DM + 4 * lane + 256 * j); } } while (0)
    LN_LOAD(0);
    for (int r = 0; r < rpw; ++r) {
        const size_t row = (size_t)(r_begin + r);
        f32x4 v[4]; v2u fwc[4];
#pragma unroll
        for (int j = 0; j < 4; ++j) { v[j] = hin32 ? nv32[j] : (f32x4){(float)nv16[j].x, (float)nv16[j].y, (float)nv16[j].z, (float)nv16[j].w}; fwc[j] = nfw[j]; }
        if (r + 1 < rpw) LN_LOAD(r + 1);
        if (do_ln) {
            float s = 0.f;
#pragma unroll
            for (int j = 0; j < 4; ++j) { const v2u fw = fwc[j];
                const f32x4 f = (f32x4){bflo(fw.x), bfhi(fw.x), bflo(fw.y), bfhi(fw.y)};
                v[j] = v[j] * DN_ALPHA + ga[j] * f; s += (v[j].x + v[j].y) + (v[j].z + v[j].w); }
            const float mean = wave_sum(s, lane) * (1.f / DM); float s2 = 0.f;
#pragma unroll
            for (int j = 0; j < 4; ++j) { v[j] = v[j] - mean; s2 += (v[j].x * v[j].x + v[j].y * v[j].y) + (v[j].z * v[j].z + v[j].w * v[j].w); }
            const float rstd = 1.f / sqrtf(wave_sum(s2, lane) * (1.f / DM) + LN_EPS);
#pragma unroll
            for (int j = 0; j < 4; ++j) v[j] = v[j] * rstd * lg[j] + lb[j];
            if (hout32) {
#pragma unroll
                for (int j = 0; j < 4; ++j) *(GAS f32x4*)(hout32 + row * DM + 4 * lane + 256 * j) = v[j];
            } else {
#pragma unroll
                for (int j = 0; j < 4; ++j) { h16x4 hv; hv.x = (_Float16)v[j].x; hv.y = (_Float16)v[j].y; hv.z = (_Float16)v[j].z; hv.w = (_Float16)v[j].w;
                    *(GAS h16x4*)(hout16 + row * DM + 4 * lane + 256 * j) = hv;
                    v[j] = (f32x4){(float)hv.x, (float)hv.y, (float)hv.z, (float)hv.w}; }
            }
        }
        if (hm) {
#pragma unroll
            for (int j = 0; j < 4; ++j) { const f32x4 o = v[j] * sc[j] + sh[j]; v2u w; w.x = pk2(o.x, o.y); w.y = pk2(o.z, o.w);
                *(GAS v2u*)(hm + row * DM + 4 * lane + 256 * j) = w; }
        }
    }
}
#undef LN_LOAD

__device__ __forceinline__ void phase_rope_tables(Frame& F, const int* positions, float* cstab, float* sntab) {
    const int gt = F.bid * (NWAVES * 64) + F.tid, NT = F.G * NWAVES * 64;
    for (int i = gt; i < MALL * 16; i += NT) { const float ang = (float)positions[i >> 4] * exp2f(-(float)(i & 15) * (13.287712379549449f / 16.0f)); cstab[i] = cosf(ang); sntab[i] = sinf(ang); }
}
__device__ __forceinline__ void phase_prep(Frame& F, const bf16* __restrict__ proj, const bf16* __restrict__ qraw, const bf16* __restrict__ kvraw, const float* __restrict__ cstab, const float* __restrict__ sntab, int tok0, bf16* __restrict__ qf, bf16* __restrict__ kf, bf16* __restrict__ vf) {
    typedef float f32x2v __attribute__((ext_vector_type(2)));
    const int gw = F.bid * NWAVES + F.wave, NGW = F.G * NWAVES, lane = F.lane, hd = lane >> 3, li = lane & 7;
    const float SC = 0.10206207261596575f * LOG2E;
#pragma unroll 2
    for (int row = gw; row < CHROWS; row += NGW) {
        const bf16* pr = proj + (size_t)row * NINP; const bf16* qr = qraw + (size_t)row * 768 + hd * 96; const bf16* kr = kvraw + (size_t)row * 1024 + hd * 128;
        const unsigned qa0 = *(const GAS unsigned*)(pr + C_QA + 6 * lane), qa1 = *(const GAS unsigned*)(pr + C_QA + 6 * lane + 2), qa2 = *(const GAS unsigned*)(pr + C_QA + 6 * lane + 4);
        const v2u ka = *(const GAS v2u*)(pr + C_KVA + 4 * lane);
        const unsigned kt1 = *(const GAS unsigned*)(pr + C_KR + 2 * li), kt2 = *(const GAS unsigned*)(pr + C_KR + 16 + 2 * li);
        const v4u qn = *(const GAS v4u*)(qr + 8 * li); const unsigned qt1 = *(const GAS unsigned*)(qr + 64 + 2 * li), qt2 = *(const GAS unsigned*)(qr + 80 + 2 * li);
        const v4u kn = *(const GAS v4u*)(kr + 8 * li), vv = *(const GAS v4u*)(kr + 64 + 8 * li);
        const f32x2v c2 = *(const GAS f32x2v*)(cstab + (size_t)(tok0 + row) * 16 + 2 * li), s2 = *(const GAS f32x2v*)(sntab + (size_t)(tok0 + row) * 16 + 2 * li);
        float sq = bflo(qa0) * bflo(qa0) + bfhi(qa0) * bfhi(qa0) + bflo(qa1) * bflo(qa1) + bfhi(qa1) * bfhi(qa1) + bflo(qa2) * bflo(qa2) + bfhi(qa2) * bfhi(qa2);
        float sk = bflo(ka.x) * bflo(ka.x) + bfhi(ka.x) * bfhi(ka.x) + bflo(ka.y) * bflo(ka.y) + bfhi(ka.y) * bfhi(ka.y);
        const float rq = rsqrtf(wave_sum(sq, lane) * (1.f / QR) + RMS_EPS) * SC, rk = rsqrtf(wave_sum(sk, lane) * (1.f / KVR) + RMS_EPS);
        bf16* qo = qf + (size_t)row * 768 + hd * 96; bf16* ko = kf + (size_t)row * 768 + hd * 96; bf16* vo = vf + (size_t)row * 512 + hd * 64;
        v4u o;
        o.x = pk2(bflo(qn.x) * rq, bfhi(qn.x) * rq); o.y = pk2(bflo(qn.y) * rq, bfhi(qn.y) * rq); o.z = pk2(bflo(qn.z) * rq, bfhi(qn.z) * rq); o.w = pk2(bflo(qn.w) * rq, bfhi(qn.w) * rq);
        *(GAS v4u*)(qo + 8 * li) = o;
        { const float a0 = bflo(qt1), a1 = bfhi(qt1), b0 = bflo(qt2), b1 = bfhi(qt2);
          *(GAS unsigned*)(qo + 64 + 2 * li) = pk2((a0 * c2.x - b0 * s2.x) * rq, (a1 * c2.y - b1 * s2.y) * rq);
          *(GAS unsigned*)(qo + 80 + 2 * li) = pk2((b0 * c2.x + a0 * s2.x) * rq, (b1 * c2.y + a1 * s2.y) * rq); }
        o.x = pk2(bflo(kn.x) * rk, bfhi(kn.x) * rk); o.y = pk2(bflo(kn.y) * rk, bfhi(kn.y) * rk); o.z = pk2(bflo(kn.z) * rk, bfhi(kn.z) * rk); o.w = pk2(bflo(kn.w) * rk, bfhi(kn.w) * rk);
        *(GAS v4u*)(ko + 8 * li) = o;
        { const float a0 = bflo(kt1), a1 = bfhi(kt1), b0 = bflo(kt2), b1 = bfhi(kt2);
          *(GAS unsigned*)(ko + 64 + 2 * li) = pk2(a0 * c2.x - b0 * s2.x, a1 * c2.y - b1 * s2.y);
          *(GAS unsigned*)(ko + 80 + 2 * li) = pk2(b0 * c2.x + a0 * s2.x, b1 * c2.y + a1 * s2.y); }
        o.x = pk2(bflo(vv.x) * rk, bfhi(vv.x) * rk); o.y = pk2(bflo(vv.y) * rk, bfhi(vv.y) * rk); o.z = pk2(bflo(vv.z) * rk, bfhi(vv.z) * rk); o.w = pk2(bflo(vv.w) * rk, bfhi(vv.w) * rk);
        *(GAS v4u*)(vo + 8 * li) = o;
    }
}

__device__ __forceinline__ void phase_dilmerge(Frame& F, const bf16* __restrict__ og, const float* __restrict__ lse2, bf16* __restrict__ ydil) {
    const int gw = F.bid * NWAVES + F.wave, NGW = F.G * NWAVES, lane = F.lane, slot = lane >> 4;
#pragma unroll 2
    for (int row = gw; row < CHROWS; row += NGW) {
        float l0 = lse2[(size_t)0 * CHROWS * 4 + (size_t)row * 4 + slot], l1 = lse2[(size_t)1 * CHROWS * 4 + (size_t)row * 4 + slot], l2 = lse2[(size_t)2 * CHROWS * 4 + (size_t)row * 4 + slot];
        const float mx = fmaxf(l0, fmaxf(l1, l2)); float w0 = exp2f(l0 - mx), w1 = exp2f(l1 - mx), w2 = exp2f(l2 - mx); const float inv = 1.0f / (w0 + w1 + w2); w0 *= inv; w1 *= inv; w2 *= inv;
        const v4u a = *(const GAS v4u*)(og + (size_t)0 * CHROWS * 512 + (size_t)row * 512 + 8 * lane), b = *(const GAS v4u*)(og + (size_t)1 * CHROWS * 512 + (size_t)row * 512 + 8 * lane), c = *(const GAS v4u*)(og + (size_t)2 * CHROWS * 512 + (size_t)row * 512 + 8 * lane);
        v4u o;
        o.x = pk2(w0 * bflo(a.x) + w1 * bflo(b.x) + w2 * bflo(c.x), w0 * bfhi(a.x) + w1 * bfhi(b.x) + w2 * bfhi(c.x));
        o.y = pk2(w0 * bflo(a.y) + w1 * bflo(b.y) + w2 * bflo(c.y), w0 * bfhi(a.y) + w1 * bfhi(b.y) + w2 * bfhi(c.y));
        o.z = pk2(w0 * bflo(a.z) + w1 * bflo(b.z) + w2 * bflo(c.z), w0 * bfhi(a.z) + w1 * bfhi(b.z) + w2 * bfhi(c.z));
        o.w = pk2(w0 * bflo(a.w) + w1 * bflo(b.w) + w2 * bflo(c.w), w0 * bfhi(a.w) + w1 * bfhi(b.w) + w2 * bfhi(c.w));
        *(GAS v4u*)(ydil + (size_t)row * 512 + 8 * lane) = o;
    }
}

template <int DK, int DV>
__device__ __forceinline__ void attn_unit_ref(Frame& F, const bf16* Qp, const bf16* Kp, long rs, const bf16* Vp, long rs_v, bf16* Op, long rs_o, float* Lp, long rs_l,
                                              int qpos0, int klo, int khi, int band, float scale2, float slope2) {
    constexpr int DKP = DK / 4, DVP = DV / 4;
    LAS unsigned char* Ks = F.lds;
    LAS unsigned char* Vs = F.lds + 64 * DK * 2;
    const int tid = F.tid, part = tid & 3, qi = tid >> 2, qpos = qpos0 + qi;
    float qv[DKP], ov[DVP];
#pragma unroll
    for (int e8 = 0; e8 < DKP / 8; ++e8) { const v4u w = *(const GAS v4u*)(Qp + (long)qpos * rs + part * DKP + e8 * 8);
        qv[e8 * 8 + 0] = bflo(w.x); qv[e8 * 8 + 1] = bfhi(w.x); qv[e8 * 8 + 2] = bflo(w.y); qv[e8 * 8 + 3] = bfhi(w.y);
        qv[e8 * 8 + 4] = bflo(w.z); qv[e8 * 8 + 5] = bfhi(w.z); qv[e8 * 8 + 6] = bflo(w.w); qv[e8 * 8 + 7] = bfhi(w.w); }
#pragma unroll
    for (int e = 0; e < DVP; ++e) ov[e] = 0.f;
    float m = -1e30f, l = 0.f;
    for (int kt = klo; kt < khi; kt += 64) {
        for (int c = tid; c < 64 * DK / 8; c += NWAVES * 64) { const int j = c / (DK / 8), cc = c % (DK / 8); const int kp = kt + j;
            v4u w = (v4u){0u, 0u, 0u, 0u}; if (kp >= 0) w = *(const GAS v4u*)(Kp + (long)kp * rs + cc * 8);
            *(LAS v4u*)(Ks + (j * DK + cc * 8) * 2) = w; }
        for (int c = tid; c < 64 * DV / 8; c += NWAVES * 64) { const int j = c / (DV / 8), cc = c % (DV / 8); const int kp = kt + j;
            v4u w = (v4u){0u, 0u, 0u, 0u}; if (kp >= 0) w = *(const GAS v4u*)(Vp + (long)kp * rs_v + cc * 8);
            *(LAS v4u*)(Vs + (j * DV + cc * 8) * 2) = w; }
        __syncthreads();
        for (int j = 0; j < 64; ++j) {
            const int kp = kt + j, dist = qpos - kp;
            float d = 0.f;
#pragma unroll
            for (int e8 = 0; e8 < DKP / 8; ++e8) { const v4u w = *(const LAS v4u*)(Ks + (j * DK + part * DKP + e8 * 8) * 2);
                d += qv[e8 * 8 + 0] * bflo(w.x) + qv[e8 * 8 + 1] * bfhi(w.x) + qv[e8 * 8 + 2] * bflo(w.y) + qv[e8 * 8 + 3] * bfhi(w.y)
                   + qv[e8 * 8 + 4] * bflo(w.z) + qv[e8 * 8 + 5] * bfhi(w.z) + qv[e8 * 8 + 6] * bflo(w.w) + qv[e8 * 8 + 7] * bfhi(w.w); }
            d += lane_xor(d, 1, tid & 63); d += lane_xor(d, 2, tid & 63);
            const bool valid = (kp >= 0) && (dist >= 0) && (dist <= band);
            if (valid) {
                const float s = d * scale2 - slope2 * (float)dist;
                const float mn = fmaxf(m, s), a = exp2f(m - mn), p = exp2f(s - mn);
                l = l * a + p; m = mn;
#pragma unroll
                for (int e8 = 0; e8 < DVP / 8; ++e8) { const v4u w = *(const LAS v4u*)(Vs + (j * DV + part * DVP + e8 * 8) * 2);
                    ov[e8 * 8 + 0] = ov[e8 * 8 + 0] * a + p * bflo(w.x); ov[e8 * 8 + 1] = ov[e8 * 8 + 1] * a + p * bfhi(w.x);
                    ov[e8 * 8 + 2] = ov[e8 * 8 + 2] * a + p * bflo(w.y); ov[e8 * 8 + 3] = ov[e8 * 8 + 3] * a + p * bfhi(w.y);
                    ov[e8 * 8 + 4] = ov[e8 * 8 + 4] * a + p * bflo(w.z); ov[e8 * 8 + 5] = ov[e8 * 8 + 5] * a + p * bfhi(w.z);
                    ov[e8 * 8 + 6] = ov[e8 * 8 + 6] * a + p * bflo(w.w); ov[e8 * 8 + 7] = ov[e8 * 8 + 7] * a + p * bfhi(w.w); }
            }
        }
        __syncthreads();
    }
    const float inv = 1.0f / l;
#pragma unroll
    for (int e8 = 0; e8 < DVP / 8; ++e8) { v4u w; w.x = pk2(ov[e8 * 8 + 0] * inv, ov[e8 * 8 + 1] * inv); w.y = pk2(ov[e8 * 8 + 2] * inv, ov[e8 * 8 + 3] * inv);
        w.z = pk2(ov[e8 * 8 + 4] * inv, ov[e8 * 8 + 5] * inv); w.w = pk2(ov[e8 * 8 + 6] * inv, ov[e8 * 8 + 7] * inv);
        *(GAS v4u*)(Op + (long)qpos * rs_o + part * DVP + e8 * 8) = w; }
    if (Lp && part == 0) Lp[(long)qpos * rs_l] = m + log2f(l);
}

__device__ __forceinline__ void phase_dilated_ref(Frame& F, const bf16* proj, bf16* og, float* lse2) {
    for (int u = F.bid; u < CHB * 3 * 4 * 32; u += F.G) {
        const int jq = u & 31, hh = (u >> 5) & 3, g = (u >> 7) % 3, b = u / 384;
        const int d = (g == 0) ? 1 : (g == 1) ? 4 : 16, bpr = 32 / d, r = jq / bpr, j = jq % bpr;
        const int head = g * 4 + hh;
        const float slope = exp2f(-8.0f * (float)(head + 1) / 12.0f);
        const bf16* Qp = proj + ((size_t)b * SEQ + r) * NINP + C_DIL + head * 128;
        bf16* Op = og + (size_t)g * CHROWS * 512 + ((size_t)b * SEQ + r) * 512 + hh * 128;
        float* Lp = lse2 + (size_t)g * CHROWS * 4 + ((size_t)b * SEQ + r) * 4 + hh;
        attn_unit_ref<128, 128>(F, Qp, Qp + 1536, (long)NINP * d, Qp + 3072, (long)NINP * d, Op, 512L * d, Lp, 4L * d,
                                128 * j, 128 * j - 128, 128 * j + 128, 128, 0.08838834764831845f * LOG2E, slope * (float)d * LOG2E);
    }
}
__device__ __forceinline__ void phase_mla_ref(Frame& F, const bf16* qf, const bf16* kf, const bf16* vf, bf16* ymla) {
    const int nun = CHB * 8 * 32;
    for (int i = 0; F.bid + i * F.G < nun; ++i) {
        int bh, jb;
        if (F.G == 256) { const int s = F.bid & 7; bh = F.bid >> 3; jb = (i == 0) ? s : (i == 1) ? 15 - s : (i == 2) ? 16 + s : 31 - s; }
        else { const int t = F.bid + i * F.G; bh = t >> 5; jb = t & 31; }
        const int b = bh >> 3, h = bh & 7;
        attn_unit_ref<96, 64>(F, qf + (size_t)b * SEQ * 768 + h * 96, kf + (size_t)b * SEQ * 768 + h * 96, 768L, vf + (size_t)b * SEQ * 512 + h * 64, 512L,
                              ymla + (size_t)b * SEQ * 512 + h * 64, 512L, nullptr, 0L, 128 * jb, 0, 128 * jb + 128, 1 << 30, 1.0f, 0.0f);
    }
}

__device__ __forceinline__ float gelu_tanh(float x) { const float t = 0.7978845608028654f * (x + 0.044715f * x * x * x); const float e = __expf(2.0f * t); const float th = 1.0f - 2.0f / (e + 1.0f); return 0.5f * x * (1.0f + th); }


namespace fa {
typedef float f32x16 __attribute__((ext_vector_type(16)));
typedef short s16x4 __attribute__((ext_vector_type(4)));
typedef short v4i16_t __attribute__((ext_vector_type(4)));
typedef float f32x2_t __attribute__((ext_vector_type(2))); typedef __bf16 bf16x2_t __attribute__((ext_vector_type(2)));
__device__ __forceinline__ unsigned cvtpk(float lo, float hi) { f32x2_t v = {lo, hi}; bf16x2_t b = __builtin_convertvector(v, bf16x2_t); return __builtin_bit_cast(unsigned, b); }
__device__ __forceinline__ s16x4 vtr(const LAS unsigned char* p) { return __builtin_bit_cast(s16x4, __builtin_amdgcn_ds_read_tr16_b64_v4i16((LAS v4i16_t*)p)); }
__device__ __forceinline__ float xhalf_other(float m) { unsigned a = __builtin_bit_cast(unsigned, m), b = a; asm volatile("" : "+v"(b));
    auto rr = __builtin_amdgcn_permlane32_swap(a, b, false, false); unsigned r0 = rr[0], r1 = rr[1]; asm volatile("" : "+v"(r0), "+v"(r1));
    return __builtin_bit_cast(float, r0) + __builtin_bit_cast(float, r1) - m; }
__device__ __forceinline__ float xhalf_max(float m) { unsigned a = __builtin_bit_cast(unsigned, m), b = a; asm volatile("" : "+v"(b));
    auto rr = __builtin_amdgcn_permlane32_swap(a, b, false, false); unsigned r0 = rr[0], r1 = rr[1]; asm volatile("" : "+v"(r0), "+v"(r1));
    return fmaxf(__builtin_bit_cast(float, r0), __builtin_bit_cast(float, r1)); }
__device__ __forceinline__ float xhalf_sum(float m) { unsigned a = __builtin_bit_cast(unsigned, m), b = a; asm volatile("" : "+v"(b));
    auto rr = __builtin_amdgcn_permlane32_swap(a, b, false, false); unsigned r0 = rr[0], r1 = rr[1]; asm volatile("" : "+v"(r0), "+v"(r1));
    return __builtin_bit_cast(float, r0) + __builtin_bit_cast(float, r1); }
__device__ __forceinline__ float max3f(float a, float b, float c) { float r; asm("v_max3_f32 %0, %1, %2, %3" : "=v"(r) : "v"(a), "v"(b), "v"(c)); return r; }
__device__ __forceinline__ float max2f(float a, float b) { float r; asm("v_max_f32_e32 %0, %1, %2" : "=v"(r) : "v"(a), "v"(b)); return r; }
constexpr int crowc(int r) { return (r & 3) + 8 * (r >> 2); }
constexpr float THR = 8.0f;

template <int DK, int DV, bool DIL>
__device__ __forceinline__ void attn_unit(Frame& F, const bf16* Qp, const bf16* Kp, long rs, const bf16* Vp, long rs_v, bf16* Op, long rs_o, float* Lp, long rs_l,
                                          int q0, int kt0, int ntiles, int band, float scale2, float slope2) {
    constexpr bool NEGM = !DIL;
    constexpr int KCH = DK / 8, VPC = (DV / 32) * 4, KBYTES = 64 * DK * 2, VBYTES = 64 * DV * 2, ND0 = DK / 16, NDB = DV / 32;
    constexpr int KOFF = 0, VOFF = 2 * KBYTES, WSF_OFF = 2 * KBYTES + 2 * VBYTES;
    static_assert(WSF_OFF + 1024 <= RING_BYTES && 8 * 32 * DV * 2 <= WSF_OFF, "attention LDS map");
    LAS unsigned char* lds = F.lds;
    const int lane = F.lane, w = F.wave, r32 = lane & 31, hi = lane >> 5;
    const int qw0 = q0 + 32 * w, qpos = qw0 + r32;
    LAS float* wsf = (LAS float*)(lds + WSF_OFF) + w * 32;
    bf16x8 qr[ND0];
#pragma unroll
    for (int d0 = 0; d0 < ND0; ++d0) qr[d0] = *(const GAS bf16x8*)(Qp + (long)qpos * rs + d0 * 16 + hi * 8);
    f32x16 o[NDB];
#pragma unroll
    for (int db = 0; db < NDB; ++db)
#pragma unroll
        for (int r = 0; r < 16; ++r) o[db][r] = 0.f;
    float m_run = -1e30f, l_run = 0.f, sh = 0.f;
    f32x16 negm; { float z0 = 0.f; asm volatile("" : "+v"(z0));
#pragma unroll
      for (int r = 0; r < 16; ++r) negm[r] = z0; }
    int t = 0; int kt = kt0;
    while (kt < 0 && t < ntiles) { kt += 64; ++t; }
#define FA_DMA(ktile, buf_) do { \
        _Pragma("unroll") for (int i = 0; i < 2; ++i) { const int c = w + 8 * i; if (c < KCH) __builtin_amdgcn_global_load_lds((const GAS unsigned*)(Kp + (long)((ktile) + lane) * rs + c * 8), (LAS unsigned*)(lds + KOFF + (buf_) * KBYTES + c * 1024), 16, 0, 0); } \
        _Pragma("unroll") for (int i = 0; i < 2; ++i) { const int pc_ = w + 8 * i; if (pc_ < VPC) __builtin_amdgcn_global_load_lds((const GAS unsigned*)(Vp + (long)((ktile) + (pc_ & 3) * 16 + (lane >> 2)) * rs_v + (pc_ >> 2) * 32 + (lane & 3) * 8), (LAS unsigned*)(lds + VOFF + (buf_) * VBYTES + pc_ * 1024), 16, 0, 0); } } while (0)
    if (t < ntiles) FA_DMA(kt, 0);
    __syncthreads();
    int buf = 0;
    for (; t < ntiles; ++t, kt += 64, buf ^= 1) {
        const bool has_next = (t + 1 < ntiles);
        if (has_next) FA_DMA(kt + 64, buf ^ 1);
        const bool skip = (kt > qw0 + 31) || (qw0 - (kt + 63) > band);
        if (!skip) {
            const bool need_mask = (qw0 - (kt + 63) < 0) || ((qw0 + 31) - kt > band);
            const LAS unsigned char* Kb = lds + KOFF + buf * KBYTES + hi * 1024 + r32 * 16;
            const LAS unsigned char* Vb = lds + VOFF + buf * VBYTES + ((lane >> 4) & 1) * 32 + (lane & 3) * 8 + (4 * hi + ((lane & 15) >> 2)) * 64;
            bf16x8 kfr[2 * ND0];
#pragma unroll
            for (int d0 = 0; d0 < ND0; ++d0) { kfr[2 * d0] = *(const LAS bf16x8*)(Kb + d0 * 2048); kfr[2 * d0 + 1] = *(const LAS bf16x8*)(Kb + d0 * 2048 + 512); }
            __builtin_amdgcn_sched_barrier(0);
            f32x16 p0, p1;
            const float shc = NEGM ? sh : 0.f;
            if constexpr (NEGM) {
#pragma unroll
                for (int d0 = 0; d0 < ND0; ++d0) {
                    p0 = __builtin_amdgcn_mfma_f32_32x32x16_bf16(kfr[2 * d0], qr[d0], d0 == 0 ? negm : p0, 0, 0, 0);
                    p1 = __builtin_amdgcn_mfma_f32_32x32x16_bf16(kfr[2 * d0 + 1], qr[d0], d0 == 0 ? negm : p1, 0, 0, 0);
                }
            } else {
#pragma unroll
                for (int r = 0; r < 16; ++r) { p0[r] = 0.f; p1[r] = 0.f; }
#pragma unroll
                for (int d0 = 0; d0 < ND0; ++d0) {
                    p0 = __builtin_amdgcn_mfma_f32_32x32x16_bf16(kfr[2 * d0], qr[d0], p0, 0, 0, 0);
                    p1 = __builtin_amdgcn_mfma_f32_32x32x16_bf16(kfr[2 * d0 + 1], qr[d0], p1, 0, 0, 0);
                }
            }
            asm volatile("s_nop 15\n\ts_nop 7" : "+v"(p0), "+v"(p1));
            if (DIL) {
                const float base0 = slope2 * (float)(kt + 4 * hi - qw0);
#pragma unroll
                for (int r = 0; r < 16; ++r) { p0[r] = p0[r] * scale2 + (base0 + slope2 * (float)crowc(r)); p1[r] = p1[r] * scale2 + (base0 + slope2 * (float)(crowc(r) + 32)); }
            }
            if (need_mask) {
                const int dq = qpos - kt - 4 * hi;
#pragma unroll
                for (int r = 0; r < 16; ++r) { const int d0_ = dq - crowc(r), d1_ = d0_ - 32;
                    p0[r] = ((unsigned)d0_ <= (unsigned)band) ? p0[r] : -1e30f; p1[r] = ((unsigned)d1_ <= (unsigned)band) ? p1[r] : -1e30f; }
            }
            float ra = max3f(p0[0], p0[1], p1[0]), rb = max3f(p0[2], p0[3], p1[1]); ra = max3f(ra, p1[2], p1[3]);
#pragma unroll
            for (int r = 4; r < 16; r += 4) { ra = max3f(ra, p0[r], p0[r + 1]); rb = max3f(rb, p0[r + 2], p0[r + 3]); ra = max3f(ra, p1[r], p1[r + 1]); rb = max3f(rb, p1[r + 2], p1[r + 3]); }
            const float rm = xhalf_max(max2f(ra, rb));
            if (__any(rm + shc > m_run + THR)) {
                const float mn = fmaxf(m_run, rm + shc), f = __builtin_amdgcn_exp2f(m_run - mn), dl = fmaxf(mn, -1e20f) - shc;
                l_run *= f; m_run = mn;
#pragma unroll
                for (int r = 0; r < 16; ++r) { p0[r] -= dl; p1[r] -= dl; }
                if (NEGM) { sh = mn;
#pragma unroll
                    for (int r = 0; r < 16; ++r) negm[r] = -mn; }
                if (hi == 0) wsf[r32] = f;
                asm volatile("" ::: "memory");
#pragma unroll
                for (int r = 0; r < 16; ++r) { const float fr_ = wsf[crowc(r) + 4 * hi];
#pragma unroll
                    for (int db = 0; db < NDB; ++db) o[db][r] *= fr_; }
            }
            else if (!NEGM) { const float mu = fmaxf(m_run, -1e20f);
#pragma unroll
                for (int r = 0; r < 16; ++r) { p0[r] -= mu; p1[r] -= mu; } }
            float ls = 0.f;
#pragma unroll
            for (int r = 0; r < 16; ++r) { p0[r] = __builtin_amdgcn_exp2f(p0[r]); p1[r] = __builtin_amdgcn_exp2f(p1[r]); ls += p0[r] + p1[r]; }
            l_run += ls;
            v4u pw[4];
#pragma unroll
            for (int s = 0; s < 2; ++s) {
                pw[s] = (v4u){cvtpk(p0[8 * s + 0], p0[8 * s + 1]), cvtpk(p0[8 * s + 2], p0[8 * s + 3]), cvtpk(p0[8 * s + 4], p0[8 * s + 5]), cvtpk(p0[8 * s + 6], p0[8 * s + 7])};
                pw[2 + s] = (v4u){cvtpk(p1[8 * s + 0], p1[8 * s + 1]), cvtpk(p1[8 * s + 2], p1[8 * s + 3]), cvtpk(p1[8 * s + 4], p1[8 * s + 5]), cvtpk(p1[8 * s + 6], p1[8 * s + 7])};
            }
#pragma unroll
            for (int db = 0; db < NDB; ++db) {
                s16x4 vlo[4], vhi[4];
#pragma unroll
                for (int ks = 0; ks < 4; ++ks) { vlo[ks] = vtr(Vb + (db * 4 + ks) * 1024); vhi[ks] = vtr(Vb + (db * 4 + ks) * 1024 + 512); }
                __builtin_amdgcn_sched_barrier(0);
#pragma unroll
                for (int ks = 0; ks < 4; ++ks) {
                    const bf16x8 vf = (bf16x8){vlo[ks][0], vlo[ks][1], vlo[ks][2], vlo[ks][3], vhi[ks][0], vhi[ks][1], vhi[ks][2], vhi[ks][3]};
                    o[db] = __builtin_amdgcn_mfma_f32_32x32x16_bf16(__builtin_bit_cast(bf16x8, pw[ks]), vf, o[db], 0, 0, 0);
                }
            }
        }
        __syncthreads();
    }
#undef FA_DMA
    const float l_tot = xhalf_sum(l_run);
    int lane_e = lane; asm volatile("" : "+v"(lane_e));
    if (hi == 0) wsf[r32] = l_tot;
    asm volatile("" ::: "memory");
    if (Lp && hi == 0) Lp[(long)qpos * rs_l] = m_run + log2f(l_tot) + (DIL ? slope2 * (float)(qw0 - qpos) : 0.f);
    LAS bf16* stg = (LAS bf16*)(lds + w * (32 * DV * 2));
#pragma unroll
    for (int r = 0; r < 16; ++r) { const int orow = crowc(r) + 4 * (lane_e >> 5); const float rl = 1.0f / wsf[orow];
#pragma unroll
        for (int db = 0; db < NDB; ++db) stg[orow * DV + db * 32 + (lane_e & 31)] = (bf16)f2bf(o[db][r] * rl); }
    asm volatile("s_waitcnt lgkmcnt(0)" ::: "memory");
#pragma unroll
    for (int i = 0; i < (32 * DV / 8) / 64; ++i) { const int id = i * 64 + lane_e, row = id / (DV / 8), ch = id % (DV / 8);
        const v4u v = *(const LAS v4u*)((const LAS unsigned char*)stg + row * (DV * 2) + ch * 16);
        *(GAS v4u*)(Op + (long)(qw0 + row) * rs_o + ch * 8) = v; }
    __syncthreads();
}
}

__device__ __forceinline__ void phase_dilated_mfma(Frame& F, const bf16* proj, bf16* og, float* lse2) {
    for (int u = F.bid; u < CHB * 3 * 4 * 16; u += F.G) {
        const int jq = u & 15, hh = (u >> 4) & 3, g = (u >> 6) % 3, b = u / 192;
        const int d = (g == 0) ? 1 : (g == 1) ? 4 : 16, bpr = 16 / d, r = jq / bpr, j = jq % bpr;
        const int head = g * 4 + hh;
        const float slope = exp2f(-8.0f * (float)(head + 1) / 12.0f);
        const bf16* Qp = proj + ((size_t)b * SEQ + r) * NINP + C_DIL + head * 128;
        bf16* Op = og + (size_t)g * CHROWS * 512 + ((size_t)b * SEQ + r) * 512 + hh * 128;
        float* Lp = lse2 + (size_t)g * CHROWS * 4 + ((size_t)b * SEQ + r) * 4 + hh;
        float sc2 = 0.08838834764831845f * LOG2E; asm volatile("" : "+v"(sc2));
        fa::attn_unit<128, 128, true>(F, Qp, Qp + 1536, (long)NINP * d, Qp + 3072, (long)NINP * d, Op, 512L * d, Lp, 4L * d,
                                      256 * j, 256 * j - 128, 6, 128, sc2, slope * (float)d * LOG2E);
    }
}
__device__ __forceinline__ void phase_mla_mfma(Frame& F, const bf16* qf, const bf16* kf, const bf16* vf, bf16* ymla) {
    for (int i = 0; i < 2; ++i) {
        const int s = F.bid & 7, bh = F.bid >> 3, qb = (i == 0) ? 15 - s : s, b = bh >> 3, h = bh & 7;
        fa::attn_unit<96, 64, false>(F, qf + (size_t)b * SEQ * 768 + h * 96, kf + (size_t)b * SEQ * 768 + h * 96, 768L, vf + (size_t)b * SEQ * 512 + h * 64, 512L,
                                     ymla + (size_t)b * SEQ * 512 + h * 64, 512L, nullptr, 0L, 256 * qb, 0, 4 * qb + 4, 1 << 30, 1.0f, 0.0f);
    }
}

#ifndef MK_MULTI
#define MK_MULTI 0
#endif
constexpr int NPHASES = 2 + DEPTH * (3 + NCHUNK * 7 + 3) + (DEPTH - 1);

__global__ void __launch_bounds__(NWAVES * 64, 2) fwd_kernel(Args args) {
    extern __shared__ __attribute__((aligned(16))) unsigned char lds[];
    Frame F;
    F.lds = (LAS unsigned char*)lds;
    F.tid = threadIdx.x; F.lane = F.tid & 63; F.wave = __builtin_amdgcn_readfirstlane(F.tid >> 6);
    F.G = 256; F.bid = blockIdx.x;
    const int bid0 = F.bid, wave0 = F.wave;
    unsigned char* ws = args.ws;
    gu32* ctl = (gu32*)(ws + WS_CTL);
    for (int u = F.tid; u < (LDS_BYTES - LDSCTL_OFF) / 4; u += NWAVES * 64) ((LAS unsigned*)(F.lds + LDSCTL_OFF))[u] = 0u;
    __syncthreads();
    (void)xcd_barrier_post((unsigned*)(ctl + CW_BAR), (volatile LAS unsigned*)(F.lds + MISC_OFF) + 8);
#define TID_NOW(ones_) ((wave0 << 6) | (int)__builtin_amdgcn_mbcnt_hi(ones_, __builtin_amdgcn_mbcnt_lo(ones_, 0u)))
#define GRID_BAR() do { size_t zofb_ = 0; asm volatile("" : "+s"(zofb_)); unsigned char* wsb = args.ws + zofb_; XcdBarrier bar_; bar_.bar = (unsigned*)(wsb + WS_CTL) + CW_BAR; bar_.x = xb_xcc_id(); bar_.st = (volatile LAS unsigned*)(F.lds + MISC_OFF) + 8; unsigned ones_b = ~0u; asm volatile("" : "+s"(ones_b)); xcd_barrier(bar_, TID_NOW(ones_b)); } while (0)
#if MK_MULTI
    const int lo = args.ph_lo, hi = args.ph_hi;
    int pc = 0;
#define SITE_BEGIN if (pc >= lo && pc < hi) { size_t zoff_ = 0; asm volatile("" : "+s"(zoff_)); unsigned char* wsl = args.ws + zoff_; F.bid = bid0; F.wave = wave0; asm volatile("" : "+s"(F.bid), "+s"(F.wave)); unsigned ones_s = ~0u; asm volatile("" : "+s"(ones_s)); F.tid = TID_NOW(ones_s); asm volatile("" : "+v"(F.tid)); F.lane = F.tid & 63;
#define SITE_END } ++pc;
#else
#define SITE_BEGIN { size_t zoff_ = 0; asm volatile("" : "+s"(zoff_)); unsigned char* wsl = args.ws + zoff_; F.bid = bid0; F.wave = wave0; asm volatile("" : "+s"(F.bid), "+s"(F.wave)); unsigned ones_s = ~0u; asm volatile("" : "+s"(ones_s)); F.tid = TID_NOW(ones_s); asm volatile("" : "+v"(F.tid)); F.lane = F.tid & 63;
#define SITE_END } GRID_BAR();
#endif
#ifdef PROF_SEL
#define SITE_BEGIN_P SITE_BEGIN const unsigned long long pf_ts = __builtin_amdgcn_s_memrealtime();
#else
#define SITE_BEGIN_P SITE_BEGIN
#endif
#ifdef PROF_SEL
#define PF_T0() ({ unsigned ones_p = ~0u; asm volatile("" : "+s"(ones_p)); TID_NOW(ones_p) == 0; })
#define PF_W() ({ size_t zofp_ = 0; asm volatile("" : "+s"(zofp_)); (unsigned long long*)(args.ws + zofp_ + WS_CTL + 768 * 1024); })
#ifndef PROF_COND
#define PROF_COND 1
#endif
#define SITE_END_C(c) const unsigned long long pf_te = __builtin_amdgcn_s_memrealtime(); const bool pf_on = ((PROF_SEL == 0) || (PROF_SEL == (c))) && (PROF_COND); \
        if (pf_on && PROF_WHAT == 1) { if (PF_T0()) __hip_atomic_fetch_add(PF_W(), pf_te - pf_ts, __ATOMIC_RELAXED, __HIP_MEMORY_SCOPE_AGENT); } GRID_BAR(); \
        if (pf_on && PROF_WHAT == 0) { const unsigned long long pf_ta = __builtin_amdgcn_s_memrealtime(); if (PF_T0()) __hip_atomic_fetch_add(PF_W(), pf_ta - pf_te, __ATOMIC_RELAXED, __HIP_MEMORY_SCOPE_AGENT); } }
#else
#define SITE_END_C(c) SITE_END
#endif
#define REP_BEGIN(n) for (int rep_ = 0; rep_ < (n); ++rep_) { if (rep_) __syncthreads();
#define REP_END }
#ifndef REP_FFN
#define REP_FFN 1
#endif
#ifndef REP_C1
#define REP_C1 1
#endif
#ifndef REP_C2
#define REP_C2 1
#endif
#ifndef REP_C3
#define REP_C3 1
#endif
#ifndef REP_LN
#define REP_LN 1
#endif
#ifndef REP_C4
#define REP_C4 1
#endif
#ifndef REP_C56
#define REP_C56 1
#endif

#define x_in ((const float*)args.in[0])
#define positions ((const int*)args.in[2])
#define ada ((float*)(wsl + WS_ADA))
#define h (args.out)
#define hm ((bf16*)(wsl + WS_HM))
#define Fs_ffn ((bf16*)(wsl + WS_F_FFN))
#define Fs_mix ((bf16*)(wsl + WS_F_MIX))
#define h16 ((_Float16*)(wsl + WS_H16))
#define gbuf ((bf16*)(wsl + WS_G))
#define proj ((bf16*)(wsl + WS_PROJ))
#define qraw ((bf16*)(wsl + WS_QRAW))
#define kvraw ((bf16*)(wsl + WS_KVRAW))
#define qf ((bf16*)(wsl + WS_QF))
#define kf ((bf16*)(wsl + WS_KF))
#define vf ((bf16*)(wsl + WS_VF))
#define ys ((bf16*)(wsl + WS_YS))
#define y3 ((bf16*)(wsl + WS_Y3))
#define og ((bf16*)(wsl + WS_OG))
#define lse2 ((float*)(wsl + WS_LSE))
#define tb ((bf16*)(wsl + WS_T))
#define ug ((bf16*)(wsl + WS_UG))
#define wb ((const unsigned char*)(wsl + WS_W))
#define lng_all ((const float*)args.in[5])
#define lnb_all ((const float*)args.in[6])
#define ada_l (ada + (size_t)l * 16 * 9216)
    for (int l = 0; l < DEPTH; ++l) {
        SITE_BEGIN_P
#ifndef SKIP_ADA
            if (l == 0) { phase_ada(F, (const float*)args.in[1], (const float*)args.in[3], (const float*)args.in[4], ada); phase_rope_tables(F, positions, (float*)(wsl + WS_ROPE), (float*)(wsl + WS_ROPE) + (size_t)MALL * 16); }
#endif
#ifndef SKIP_WCONV
            phase_wconv(F, args, l);
#endif
#ifdef DUP_WCONV
            phase_wconv(F, args, l);
#endif
        SITE_END_C(1)
        if (l == 0) {
            SITE_BEGIN_P
                phase_lnmod(F, false, x_in, nullptr, nullptr, nullptr, nullptr, hm, 0, MALL, nullptr, 0.f, nullptr, nullptr, ada + 0);
            SITE_END_C(2)
        }
        for (int half = 0; half < 2; ++half) {
            const int s = half * 2;
            SITE_BEGIN_P
            REP_BEGIN(REP_FFN)
                if (half == 0) phase_ssm_weights(F, wsl);
#ifdef DUP_WCONV
                if (half == 0) phase_ssm_weights(F, wsl);
#endif
                pg8::Gemm g{hm, (const bf16*)(wb + W_13 + half * W_13_SZ), MALL, 2 * DFF, DM, DM, DM, 0, 0};
                pg8::StaticOrder S; S.init(MALL, 2 * DFF, F.G, F.bid);
                pg8::EpiSwiGLU E{gbuf, DFF};
                pg8::gemm_phase<pg8::EpiSwiGLU, pg8::StaticOrder, true, true>(F.lds + RING_OFF, g, S, E, F.tid);
            REP_END
            SITE_END_C(3)
            SITE_BEGIN_P
            REP_BEGIN(REP_FFN)
                pg8::Gemm g{gbuf, (const bf16*)(wb + W_2 + half * W_2_SZ), MALL, DM, DFF, DFF, DFF, 0, 0};
                pg8::StaticOrder S; S.init(MALL, DM, F.G, F.bid);
                pg8::EpiStore E{Fs_ffn, DM, nullptr};
                pg8::gemm_phase<pg8::EpiStore, pg8::StaticOrder, true, true>(F.lds + RING_OFF, g, S, E, F.tid);
            REP_END
            SITE_END_C(4)
            SITE_BEGIN_P
                const bool last = (l == DEPTH - 1) && (half == 1);
                const bool first = (l == 0 && half == 0);
                const float* ada_next = (half == 0) ? ada_l + 1 * 3072 : ada_l + (size_t)16 * 9216 + 0;
                phase_lnmod(F, true, first ? x_in : nullptr, first ? nullptr : h16, Fs_ffn, last ? h : nullptr, last ? nullptr : h16, last ? nullptr : hm, 0, MALL, ada_l + s * 3072 + 2048, 0.5f, lng_all + ((size_t)l * 3 + s) * DM, lnb_all + ((size_t)l * 3 + s) * DM, ada_next);
            SITE_END_C(5)
            if (half == 1) break;
            for (int c = 0; c < NCHUNK; ++c) {
                const int tok0 = c * CHROWS;
                SITE_BEGIN_P
                REP_BEGIN(REP_C1)
                    pg8::Gemm g{hm + (size_t)tok0 * DM, (const bf16*)(wb + W_IN), CHROWS, NINP, DM, DM, DM, 0, 0};
                    pg8::StaticOrder S; S.init(CHROWS, NINP, F.G, F.bid);
                    pg8::EpiInProj E{proj, NINP, (const float*)(wsl + WS_SMALL + SM_BIAS), ug, C_U / 256, SSM_NR, SSM_KE};
                    pg8::gemm_phase<pg8::EpiInProj, pg8::StaticOrder, true, true>(F.lds + RING_OFF, g, S, E, F.tid);
                REP_END
                SITE_END_C(6)
                SITE_BEGIN_P
                REP_BEGIN(REP_C2)
                    { pg8::Gemm g{proj + C_QA, (const bf16*)(wb + W_QB), CHROWS, 768, QR, NINP, QR, 0, 0};
                      pg8::StaticOrder S; S.init(CHROWS, 768, F.G, F.bid);
                      pg8::EpiStore E{qraw, 768, nullptr};
                      pg8::gemm_phase<pg8::EpiStore, pg8::StaticOrder, true, true>(F.lds + RING_OFF, g, S, E, F.tid); }
#ifdef DUP_Q
                    __syncthreads();
                    { pg8::Gemm g{proj + C_QA, (const bf16*)(wb + W_QB), CHROWS, 768, QR, NINP, QR, 0, 0};
                      pg8::StaticOrder S; S.init(CHROWS, 768, F.G, F.bid);
                      pg8::EpiStore E{qraw, 768, nullptr};
                      pg8::gemm_phase<pg8::EpiStore, pg8::StaticOrder, true, true>(F.lds + RING_OFF, g, S, E, F.tid); }
#endif
                    { pg8::Gemm g{proj + C_KVA, (const bf16*)(wb + W_KVB), CHROWS, 1024, KVR, NINP, KVR, 0, 0};
                      pg8::StaticOrder S; S.init(CHROWS, 1024, F.G, F.bid);
                      pg8::EpiStore E{kvraw, 1024, nullptr};
                      pg8::gemm_phase<pg8::EpiStore, pg8::StaticOrder, true, true>(F.lds + RING_OFF, g, S, E, F.tid); }
#ifdef DUP_KV
                    __syncthreads();
                    { pg8::Gemm g{proj + C_KVA, (const bf16*)(wb + W_KVB), CHROWS, 1024, KVR, NINP, KVR, 0, 0};
                      pg8::StaticOrder S; S.init(CHROWS, 1024, F.G, F.bid);
                      pg8::EpiStore E{kvraw, 1024, nullptr};
                      pg8::gemm_phase<pg8::EpiStore, pg8::StaticOrder, true, true>(F.lds + RING_OFF, g, S, E, F.tid); }
#endif
                    { pg8::Gemm g{ug, (const bf16*)(wb + W_SS), 32 * SSM_NR, 256, 256, SSM_KE, 256, 0, 0, 4, 256L * 256};
                      pg8::StaticOrder S; S.init(32 * SSM_NR, 256, F.G, F.bid);
                      pg8::EpiSsmState E{ug, (const float*)(wsl + WS_SMALL + SM_DEC), SSM_KE};
                      pg8::gemm_phase<pg8::EpiSsmState, pg8::StaticOrder, false, true>(F.lds + RING_OFF, g, S, E, F.tid); }
#ifdef DUP_ST
                    __syncthreads();
                    { pg8::Gemm g{ug, (const bf16*)(wb + W_SS), 32 * SSM_NR, 256, 256, SSM_KE, 256, 0, 0, 4, 256L * 256};
                      pg8::StaticOrder S; S.init(32 * SSM_NR, 256, F.G, F.bid);
                      pg8::EpiSsmState E{ug, (const float*)(wsl + WS_SMALL + SM_DEC), SSM_KE};
                      pg8::gemm_phase<pg8::EpiSsmState, pg8::StaticOrder, false, true>(F.lds + RING_OFF, g, S, E, F.tid); }
#endif
                    __syncthreads();
                    phase_dilated_mfma(F, proj, og, lse2);
#ifdef DUP_DIL
                    __syncthreads(); phase_dilated_mfma(F, proj, og, lse2);
#endif
                REP_END
                SITE_END_C(7)
                SITE_BEGIN_P
                REP_BEGIN(REP_C3)
#ifndef SKIP_PREP
                    phase_prep(F, proj, qraw, kvraw, (const float*)(wsl + WS_ROPE), (const float*)(wsl + WS_ROPE) + (size_t)MALL * 16, tok0, qf, kf, vf);
#ifdef DUP_PREP
                    phase_prep(F, proj, qraw, kvraw, (const float*)(wsl + WS_ROPE), (const float*)(wsl + WS_ROPE) + (size_t)MALL * 16, tok0, qf, kf, vf);
#endif
#endif
                    phase_dilmerge(F, og, lse2, y3 + (size_t)1 * CHROWS * 512);
#ifdef DUP_DM
                    phase_dilmerge(F, og, lse2, y3 + (size_t)1 * CHROWS * 512);
#endif
                    { pg8::Gemm g{ug, (const bf16*)(wb + W_SM), 32 * SSM_NR, 256, SSM_KE, SSM_KE, SSM_KE, 0, 0, 4, 256L * SSM_KE};
                      pg8::StaticOrder S; S.init(32 * SSM_NR, 256, F.G, F.bid);
                      pg8::EpiSsmMain E{ys, 512, ug, SSM_KE, SSM_NR, (const float*)args.in[23] + l * 512};
                      pg8::gemm_phase<pg8::EpiSsmMain, pg8::StaticOrder, true, true>(F.lds + RING_OFF, g, S, E, F.tid); }
#ifdef DUP_SM
                    __syncthreads();
                    { pg8::Gemm g{ug, (const bf16*)(wb + W_SM), 32 * SSM_NR, 256, SSM_KE, SSM_KE, SSM_KE, 0, 0, 4, 256L * SSM_KE};
                      pg8::StaticOrder S; S.init(32 * SSM_NR, 256, F.G, F.bid);
                      pg8::EpiSsmMain E{ys, 512, ug, SSM_KE, SSM_NR, (const float*)args.in[23] + l * 512};
                      pg8::gemm_phase<pg8::EpiSsmMain, pg8::StaticOrder, true, true>(F.lds + RING_OFF, g, S, E, F.tid); }
#endif
                REP_END
                SITE_END_C(8)
                SITE_BEGIN_P
                REP_BEGIN(REP_C4)
                    phase_mla_mfma(F, qf, kf, vf, y3);
                    __syncthreads();
                    { pg8::Gemm g{ys, (const bf16*)(wb + W_GLU), CHROWS, 512, 512, 512, 512, 0, 0};
                      pg8::StaticOrder S; S.init(CHROWS, 512, F.G, F.bid);
                      pg8::EpiGLU E{y3 + (size_t)2 * CHROWS * 512, 512, ys, 512, (const float*)args.in[25] + l * 512};
                      pg8::gemm_phase<pg8::EpiGLU, pg8::StaticOrder, true, true>(F.lds + RING_OFF, g, S, E, F.tid); }
#ifdef DUP_GLU
                    __syncthreads();
                    { pg8::Gemm g{ys, (const bf16*)(wb + W_GLU), CHROWS, 512, 512, 512, 512, 0, 0};
                      pg8::StaticOrder S; S.init(CHROWS, 512, F.G, F.bid);
                      pg8::EpiGLU E{y3 + (size_t)2 * CHROWS * 512, 512, ys, 512, (const float*)args.in[25] + l * 512};
                      pg8::gemm_phase<pg8::EpiGLU, pg8::StaticOrder, true, true>(F.lds + RING_OFF, g, S, E, F.tid); }
#endif
                REP_END
                SITE_END_C(9)
                SITE_BEGIN_P
                REP_BEGIN(REP_C56)
                    pg8::Gemm g{y3, (const bf16*)(wb + W_BR), CHROWS, 3072, 512, 512, 512, 4, (long)CHROWS * 512};
                    pg8::BranchOrder S; S.init(CHROWS, F.G, F.bid);
                    pg8::EpiGateAcc E{(float*)tb, tb + (size_t)CHROWS * 2048, DM, proj + C_GATE, NINP};
                    pg8::gemm_phase<pg8::EpiGateAcc, pg8::BranchOrder, true, true>(F.lds + RING_OFF, g, S, E, F.tid);
                REP_END
                SITE_END_C(10)
                SITE_BEGIN_P
                REP_BEGIN(REP_C56)
                    pg8::Gemm g{tb + (size_t)CHROWS * 2048, (const bf16*)(wb + W_OUT), CHROWS, DM, DM, DM, DM, 0, 0};
                    pg8::StaticOrder S; S.init(CHROWS, DM, F.G, F.bid);
                    pg8::EpiStore E{Fs_mix, DM, nullptr};
                    pg8::gemm_phase<pg8::EpiStore, pg8::StaticOrder, true, true>(F.lds + RING_OFF, g, S, E, F.tid);
                REP_END
                SITE_END_C(11)
                SITE_BEGIN_P
                    phase_lnmod(F, true, nullptr, h16, Fs_mix, nullptr, h16, hm, tok0, CHROWS, ada_l + 1 * 3072 + 2048, 1.0f, lng_all + ((size_t)l * 3 + 1) * DM, lnb_all + ((size_t)l * 3 + 1) * DM, ada_l + 2 * 3072);
                SITE_END_C(12)
            }
        }
    }
#ifdef PROF_SEL
    { GRID_BAR();
      if (bid0 == 0 && PF_T0()) { const unsigned long long tot = __hip_atomic_load(PF_W(), __ATOMIC_RELAXED, __HIP_MEMORY_SCOPE_AGENT); const unsigned long long dl = tot / 256;
          const unsigned long long t0 = __builtin_amdgcn_s_memrealtime(); while (__builtin_amdgcn_s_memrealtime() - t0 < dl) __builtin_amdgcn_s_sleep(8); } }
#endif
#undef SITE_BEGIN
#undef SITE_END
#undef x_in
#undef positions
#undef ada
#undef h
#undef hm
#undef Fs_ffn
#undef Fs_mix
#undef h16
#undef gbuf
#undef proj
#undef qraw
#undef kvraw
#undef qf
#undef kf
#undef vf
#undef ys
#undef y3
#undef og
#undef lse2
#undef tb
#undef ug
#undef wb
#undef lng_all
#undef lnb_all
#undef ada_l
}

extern "C" void kernel_launch(void* const* d_in, const int* in_sizes, int n_in, void* d_out, int out_size, void* d_ws, size_t ws_size, hipStream_t stream) {
    static int grid = 0;
    if (grid == 0) {
        if (n_in != 28 || in_sizes[0] != MALL * DM || out_size != MALL * DM || ws_size < WS_END || ws_size < WS_G + (size_t)MALL * DFF * 2) {
            fprintf(stderr, "kernel_launch: unexpected problem shape (n_in %d, in0 %d, out %d, ws %zu); nothing launched\n", n_in, n_in > 0 ? in_sizes[0] : -1, out_size, ws_size); grid = -1; return; }
        int dev = 0, cus = 0, per_cu = 0;
        if (hipGetDevice(&dev) != hipSuccess || hipDeviceGetAttribute(&cus, hipDeviceAttributeMultiprocessorCount, dev) != hipSuccess) { grid = -1; return; }
        if (hipFuncSetAttribute((const void*)fwd_kernel, hipFuncAttributeMaxDynamicSharedMemorySize, LDS_BYTES) != hipSuccess) { fprintf(stderr, "kernel_launch: hipFuncSetAttribute failed\n"); grid = -1; return; }
        if (hipOccupancyMaxActiveBlocksPerMultiprocessor(&per_cu, (const void*)fwd_kernel, NWAVES * 64, LDS_BYTES) != hipSuccess || per_cu < 1)
            fprintf(stderr, "kernel_launch: note: occupancy query reports %d workgroups per CU\n", per_cu);
        (void)hipGetLastError();
        grid = cus;
        if (grid != 256) { fprintf(stderr, "kernel_launch: built for a 256-CU device, found %d CUs; nothing launched\n", cus); grid = -1; return; }
    }
    if (grid < 0) return;
    if (hipMemsetAsync((char*)d_ws + WS_CTL, 0, CTL_ZERO_BYTES, stream) != hipSuccess) return;
    Args a{};
    for (int i = 0; i < 28; ++i) a.in[i] = d_in[i];
    a.out = (float*)d_out; a.ws = (unsigned char*)d_ws;
#if MK_MULTI
    for (int p = 0; p < NPHASES; ++p) { a.ph_lo = p; a.ph_hi = p + 1; hipLaunchKernelGGL(fwd_kernel, dim3(grid), dim3(NWAVES * 64), LDS_BYTES, stream, a); }
#else
    a.ph_lo = 0; a.ph_hi = NPHASES;
    hipLaunchKernelGGL(fwd_kernel, dim3(grid), dim3(NWAVES * 64), LDS_BYTES, stream, a);
#endif
    const hipError_t le = hipPeekAtLastError();
    if (le != hipSuccess) fprintf(stderr, "kernel_launch: launch failed: %s\n", hipGetErrorName(le));
}
```
